# Optimizing an MI355X kernel written in HIP

```python
import math
import jax
import jax.numpy as jnp
from jax import lax
import numpy as np

D_MODEL = 2048
BATCH = 16
SEQ = 256
DEPTH = 2
DEC_BATCH = 4
DEC_SEQ = 2048
PAST_LEN = 256

GRID_W = 64
EPS = 1e-6
HEAD_DIM = 128
A_HEADS = D_MODEL // 256
A_KV_HEADS = A_HEADS // 4
A_WIDTH = A_HEADS * HEAD_DIM
KV_WIDTH = A_KV_HEADS * HEAD_DIM
Q_BLOCK = 128
ROPE_THETA = 10000.0
ATTN_SCALE = HEAD_DIM ** -0.5
CHUNK = 128
B_GROUPS = 4
B_WIDTH = D_MODEL // 4
B_GC = B_WIDTH // B_GROUPS
POOL_WINDOWS = (2, 4, 8, 16)
C_GROUPS = 4
C_WIDTH = D_MODEL // 4
C_GC = C_WIDTH // C_GROUPS
N_BRANCH = 3
IN_SPLITS = (A_WIDTH, KV_WIDTH, KV_WIDTH, A_WIDTH, B_WIDTH, B_WIDTH, B_WIDTH, C_WIDTH, C_WIDTH)
IN_COLS = 2 * A_WIDTH + 2 * KV_WIDTH + 3 * B_WIDTH + 2 * C_WIDTH

kernel_name = "hybrid_ctx_prefix_gqa_sgu_pool_step"


def _rmsnorm(x, w):
    xf = x.astype(jnp.float32)
    y = xf * lax.rsqrt(jnp.mean(xf * xf, axis=-1, keepdims=True) + EPS)
    return (y * w.astype(jnp.float32)).astype(x.dtype)


def _split_cols(proj):
    idx = []
    acc = 0
    for s in IN_SPLITS[:-1]:
        acc += s
        idx.append(acc)
    return jnp.split(proj, idx, axis=-1)


def _axial_rope_tables(n_tokens):
    rows = n_tokens // GRID_W
    row = jnp.repeat(jnp.arange(rows), GRID_W).astype(jnp.float32)
    col = jnp.tile(jnp.arange(GRID_W), rows).astype(jnp.float32)
    n_freq = HEAD_DIM // 4
    inv = ROPE_THETA ** (-jnp.arange(n_freq, dtype=jnp.float32) / n_freq)
    ang_r = row[:, None] * inv[None, :]
    ang_c = col[:, None] * inv[None, :]
    return (jnp.cos(ang_r), jnp.sin(ang_r), jnp.cos(ang_c), jnp.sin(ang_c))


def _rotate(xh, cos, sin):
    f = xh.shape[-1] // 2
    x1, x2 = xh[..., :f], xh[..., f:]
    cos = cos[None, :, None, :]
    sin = sin[None, :, None, :]
    return jnp.concatenate([x1 * cos - x2 * sin, x2 * cos + x1 * sin], axis=-1)


def _apply_axial_rope(x, tables):
    cr, sr, cc, sc = tables
    xf = x.astype(jnp.float32)
    half = HEAD_DIM // 2
    out = jnp.concatenate([_rotate(xf[..., :half], cr, sr), _rotate(xf[..., half:], cc, sc)], axis=-1)
    return out.astype(x.dtype)


def _block_attention(q, k, v):
    b, s = q.shape[0], q.shape[1]
    g = A_HEADS // A_KV_HEADS
    nb = s // Q_BLOCK
    qb = q.reshape(b, nb, Q_BLOCK, A_KV_HEADS, g, HEAD_DIM).transpose(1, 0, 2, 3, 4, 5)
    kf = k.astype(jnp.float32)
    vf = v.astype(jnp.float32)

    def one_block(qblk):
        sc = jnp.einsum('bqkgd,btkd->bkgqt', qblk.astype(jnp.float32), kf) * ATTN_SCALE
        p = jax.nn.softmax(sc, axis=-1)
        return jnp.einsum('bkgqt,btkd->bqkgd', p, vf).astype(q.dtype)

    o = lax.map(one_block, qb)
    return o.transpose(1, 0, 2, 3, 4, 5).reshape(b, s, A_WIDTH)


def _chunk_sgu(u, v, norm_w, w_s, b_s):
    b, s, _ = v.shape
    vc = _rmsnorm(v, norm_w).reshape(b, s // CHUNK, CHUNK, B_GROUPS, B_GC)
    mixed = jnp.einsum('gpq,bnqgc->bnpgc', w_s, vc) + b_s.T[None, None, :, :, None]
    return u * mixed.reshape(b, s, B_WIDTH)


def _multiscale_pool(z, w_pool, pool_scale):
    b, s, _ = z.shape
    zf = z.astype(jnp.float32)
    cs = jnp.concatenate([jnp.zeros((b, 1, C_WIDTH), jnp.float32), jnp.cumsum(zf, axis=1)], axis=1)
    t = jnp.arange(s)
    outs = []
    for gi, w in enumerate(POOL_WINDOWS):
        lo = jnp.clip(t - w // 2, 0, s)
        hi = jnp.clip(t + w - w // 2, 0, s)
        sl = slice(gi * C_GC, (gi + 1) * C_GC)
        cnt = (hi - lo).astype(jnp.float32)[None, :, None]
        d = (cs[:, hi, sl] - cs[:, lo, sl]) / cnt - zf[..., sl]
        outs.append(jnp.einsum('bsc,cd->bsd', d, w_pool[gi].astype(jnp.float32)))
    out = jnp.concatenate(outs, axis=-1) * pool_scale.astype(jnp.float32)
    return out.astype(z.dtype)


def _mixer_layer(x, mod, rope_tables, ctx_k, ctx_v, norm_w, w_in, q_norm_w, k_norm_w,
                 sgu_norm_w, w_sgu, b_sgu, w_pool, pool_scale, w_br_a, w_br_b, w_br_c,
                 w_merge, b_merge, w_out):
    b, s, _ = x.shape
    shift, scale, gate = jnp.split(mod.astype(x.dtype), 3, axis=-1)
    h = _rmsnorm(x, norm_w) * (1.0 + scale) + shift
    q, k, v, ga, u, vb, gb, z, gc = _split_cols(h @ w_in)
    q = _rmsnorm(q.reshape(b, s, A_HEADS, HEAD_DIM), q_norm_w)
    k = _rmsnorm(k.reshape(b, s, A_KV_HEADS, HEAD_DIM), k_norm_w)
    v = v.reshape(b, s, A_KV_HEADS, HEAD_DIM)
    k_plain = k
    if rope_tables is None:
        keys, vals = k, v
    else:
        q = _apply_axial_rope(q, rope_tables)
        keys = jnp.concatenate([_apply_axial_rope(k, rope_tables), ctx_k.astype(x.dtype)], axis=1)
        vals = jnp.concatenate([v, ctx_v.astype(x.dtype)], axis=1)
    attn = _block_attention(q, keys, vals) * jax.nn.silu(ga)
    bout = _chunk_sgu(u, vb, sgu_norm_w, w_sgu, b_sgu) * jax.nn.silu(gb)
    cout = _multiscale_pool(z, w_pool, pool_scale) * jax.nn.silu(gc)
    gates = jax.nn.sigmoid((h @ w_merge + b_merge).astype(jnp.float32)).astype(x.dtype)
    gates = gates.reshape(b, s, N_BRANCH, D_MODEL)
    merged = (gates[:, :, 0] * (attn @ w_br_a)
              + gates[:, :, 1] * (bout @ w_br_b)
              + gates[:, :, 2] * (cout @ w_br_c))
    out = merged @ w_out
    return x + gate * out, k_plain, v


def setup_inputs(seed: int = 0) -> dict:
    key = jax.random.key(seed)
    ks = jax.random.split(key, 32)
    nrm = jax.random.normal
    f32 = jnp.float32
    d = D_MODEL
    return {
        "x_prompt": nrm(ks[0], (BATCH, SEQ, d), f32),
        "x_sample": nrm(ks[1], (DEC_BATCH, DEC_SEQ, d), f32),
        "cache_k": nrm(ks[2], (DEC_BATCH, DEPTH, PAST_LEN, A_KV_HEADS, HEAD_DIM), f32),
        "cache_v": nrm(ks[3], (DEC_BATCH, DEPTH, PAST_LEN, A_KV_HEADS, HEAD_DIM), f32),
        "c": nrm(ks[4], (DEC_BATCH, d), f32),
        "c_ctx": nrm(ks[5], (d,), f32),
        "norm_w": 1.0 + 0.02 * nrm(ks[6], (DEPTH, d), f32),
        "w_ada": 0.5 * d ** -0.5 * nrm(ks[7], (DEPTH, d, 3 * d), f32),
        "b_ada": 0.01 * nrm(ks[8], (DEPTH, 3 * d), f32),
        "w_in": d ** -0.5 * nrm(ks[9], (DEPTH, d, IN_COLS), f32),
        "q_norm_w": 1.0 + 0.02 * nrm(ks[10], (DEPTH, HEAD_DIM), f32),
        "k_norm_w": 1.0 + 0.02 * nrm(ks[11], (DEPTH, HEAD_DIM), f32),
        "sgu_norm_w": 1.0 + 0.02 * nrm(ks[12], (DEPTH, B_WIDTH), f32),
        "w_sgu": CHUNK ** -0.5 * nrm(ks[13], (DEPTH, B_GROUPS, CHUNK, CHUNK), f32),
        "b_sgu": 0.02 * nrm(ks[14], (DEPTH, B_GROUPS, CHUNK), f32),
        "w_pool": C_GC ** -0.5 * nrm(ks[15], (DEPTH, C_GROUPS, C_GC, C_GC), f32),
        "pool_scale": 1.0 + 0.02 * nrm(ks[16], (DEPTH, C_WIDTH), f32),
        "w_br_a": A_WIDTH ** -0.5 * nrm(ks[17], (DEPTH, A_WIDTH, d), f32),
        "w_br_b": B_WIDTH ** -0.5 * nrm(ks[18], (DEPTH, B_WIDTH, d), f32),
        "w_br_c": C_WIDTH ** -0.5 * nrm(ks[19], (DEPTH, C_WIDTH, d), f32),
        "w_merge": d ** -0.5 * nrm(ks[20], (DEPTH, d, N_BRANCH * d), f32),
        "b_merge": 0.01 * nrm(ks[21], (DEPTH, N_BRANCH * d), f32),
        "w_out": d ** -0.5 * nrm(ks[22], (DEPTH, d, d), f32),
        "final_norm_w": 1.0 + 0.02 * nrm(ks[23], (d,), f32),
    }


def reference(x_prompt, x_sample, cache_k, cache_v, c, c_ctx, norm_w, w_ada, b_ada, w_in,
              q_norm_w, k_norm_w, sgu_norm_w, w_sgu, b_sgu, w_pool, pool_scale,
              w_br_a, w_br_b, w_br_c, w_merge, b_merge, w_out, final_norm_w):
    rope_tables = _axial_rope_tables(x_sample.shape[1])
    xp = x_prompt
    xs = x_sample
    ks_out = []
    vs_out = []
    for l in range(DEPTH):
        lp = (norm_w[l], w_in[l], q_norm_w[l], k_norm_w[l], sgu_norm_w[l], w_sgu[l], b_sgu[l],
              w_pool[l], pool_scale[l], w_br_a[l], w_br_b[l], w_br_c[l], w_merge[l], b_merge[l],
              w_out[l])
        mod_ctx = (jax.nn.silu(c_ctx) @ w_ada[l] + b_ada[l])[None, None, :]
        xp, k_l, v_l = _mixer_layer(xp, mod_ctx, None, None, None, *lp)
        ks_out.append(k_l)
        vs_out.append(v_l)
        mod_lat = (jax.nn.silu(c) @ w_ada[l] + b_ada[l])[:, None, :]
        xs, _, _ = _mixer_layer(xs, mod_lat, rope_tables, cache_k[:, l], cache_v[:, l], *lp)
    y_prompt = _rmsnorm(xp, final_norm_w)
    y_sample = _rmsnorm(xs, final_norm_w)
    state_k = jnp.stack(ks_out, axis=1)
    state_v = jnp.stack(vs_out, axis=1)
    return (y_prompt, y_sample, state_k, state_v)
```

```cpp
#include <hip/hip_runtime.h>
#include <hip/hip_bf16.h>
#include <cstdio>
#include <cstdint>
namespace pg8 {
#define PG8_LAS __attribute__((address_space(3)))
typedef unsigned short bf16_t;
typedef short bf16x8 __attribute__((ext_vector_type(8)));
typedef float f32x4 __attribute__((ext_vector_type(4)));
typedef unsigned u32x4 __attribute__((ext_vector_type(4)));
constexpr int BM = 256, BK = 64, HALF = 128, HTB = HALF * BK * 2  , STAGE_BYTES = 8 * HTB, NXCD = 8, WGM = 8;

__host__ __device__ __forceinline__ int lds_byte(int r, int c) { const int st = (r >> 4) * 2 + (c >> 5), rr = r & 15, cc = c & 31, ob = rr * 64 + cc * 2; return st * 1024 + (ob ^ (((ob >> 9) & 1) << 5)); }
__host__ __device__ __forceinline__ void stage_rc(int b, int& R, int& C) { const int st = b / 1024, sb = b % 1024, swz = sb ^ (((sb >> 9) & 1) << 5); R = (st >> 1) * 16 + swz / 64; C = (st & 1) * 32 + (swz % 64) / 2; }
__host__ __device__ __forceinline__ int perm32(int rho) { const int n = rho >> 4, i = rho & 15; return 8 * (i >> 2) + 4 * n + (i & 3); }

struct Unit { int pm, pn, type; };
struct Gemm { const bf16_t* A; const bf16_t* Bt; int M, N, K, lda; };

struct StaticOrder {
    int nM, nN, nwg, G, c;
    __host__ __device__ void init(int M, int N, int G_, int c_) { nM = M / BM; nN = N / BM; nwg = nM * nN; G = G_; c = c_; }
    __host__ __device__ bool next(int i, Unit& u) const {
        const long L = (long)i * G + c; if (L >= nwg) return false;
        int wgid = (int)L; { const int q = nwg / NXCD, r = nwg % NXCD, xcd = wgid % NXCD, off = wgid / NXCD; wgid = (xcd < r ? xcd * (q + 1) : r * (q + 1) + (xcd - r) * q) + off; }
        const int nig = WGM * nN, gid = wgid / nig, fm = gid * WGM, gsz = (nM - fm) < WGM ? (nM - fm) : WGM;
        u.pm = fm + ((wgid % nig) % gsz); u.pn = (wgid % nig) / gsz; u.type = 0; return true;
    }
    __device__ __forceinline__ void a_ready(const Unit&) const {}
    __device__ __forceinline__ void done(const Unit&) const {}
};

__device__ __forceinline__ unsigned cvt_pk_bf16(float lo, float hi) { unsigned r; asm volatile("v_cvt_pk_bf16_f32 %0, %1, %2" : "=v"(r) : "v"(lo), "v"(hi)); return r; }
typedef float f32x2 __attribute__((ext_vector_type(2)));
template <class Epi, class Sched, bool ALIGN_EPI = false, bool SP2 = false>
__device__ __forceinline__ void gemm_phase(PG8_LAS unsigned char* lds, const Gemm g, const Sched& S, const Epi& E) {
    int tid_ = threadIdx.x; asm volatile("" : "+v"(tid_)); const int tid = tid_, wid = __builtin_amdgcn_readfirstlane(tid >> 6), lane = tid & 63, wr = wid >> 2, wc = wid & 3, fr = lane & 15, fq = lane >> 4;
    const int K = g.K, nt = K / BK;
    unsigned voffA[2], voffB[2];
#pragma unroll
    for (int i = 0; i < 2; ++i) { int R, C; stage_rc(tid * 16 + i * 8192, R, C); const int Rb = Epi::PERM ? ((R & ~31) + perm32(R & 31)) : R;
        voffA[i] = (unsigned)(R * g.lda + C) * 2u; voffB[i] = (unsigned)(Rb * K + C) * 2u; }
    const size_t kstep = (size_t)(BK * 2);
    const size_t hstep = (size_t)HALF * K * 2;
    const size_t tstep = 2 * hstep; const size_t hstepA = (size_t)HALF * g.lda * 2, tstepA = 2 * hstepA;
    const unsigned ldsw = (unsigned)wid * 1024u;
    const int aoff = lds_byte(wr * 64 + fr, fq * 8), boff = lds_byte(wc * 32 + fr, fq * 8);
#define PG8_SA(b, h) (((b) * 2 + (h)) * HTB)
#define PG8_SB(b, h) ((4 + (b) * 2 + (h)) * HTB)
#define PG8_STAGE(bufoff, gbase, voff) do { _Pragma("unroll") for (int _i = 0; _i < 2; ++_i) \
        __builtin_amdgcn_global_load_lds((const unsigned*)((const char*)(gbase) + (voff)[_i]), (PG8_LAS unsigned*)(lds + (bufoff) + ldsw + _i * 8192), 16, 0, 0); } while (0)
#define PG8_LDA(dst, b, h) do { _Pragma("unroll") for (int m = 0; m < 4; ++m) _Pragma("unroll") for (int k = 0; k < 2; ++k) dst[m][k] = *(const PG8_LAS bf16x8*)(lds + PG8_SA(b, h) + aoff + m * 2048 + k * 1024); } while (0)
#define PG8_LDB(dst, b, h) do { _Pragma("unroll") for (int n = 0; n < 2; ++n) _Pragma("unroll") for (int k = 0; k < 2; ++k) dst[n][k] = *(const PG8_LAS bf16x8*)(lds + PG8_SB(b, h) + boff + n * 2048 + k * 1024); } while (0)
#define PG8_MMA(ai, bj, At, Bt) do { __builtin_amdgcn_s_setprio(1); _Pragma("unroll") for (int m = 0; m < 4; ++m) _Pragma("unroll") for (int n = 0; n < 2; ++n) _Pragma("unroll") for (int k = 0; k < 2; ++k) \
        acc[ai][bj][m][n] = __builtin_amdgcn_mfma_f32_16x16x32_bf16(Bt[n][k], At[m][k], acc[ai][bj][m][n], 0, 0, 0); __builtin_amdgcn_s_setprio(0); } while (0)
#define PG8_WAIT_V(n) asm volatile("s_waitcnt vmcnt(" #n ")" ::: "memory")
#define PG8_WAIT_L(n) asm volatile("s_waitcnt lgkmcnt(" #n ")" ::: "memory")
#define PG8_BAR __builtin_amdgcn_s_barrier()
#define PG8_SCHED __builtin_amdgcn_sched_barrier(0)
    Unit cur, nxt; int ui = 0;
    if (!S.next(0, cur)) return;
    f32x4 acc[2][2][4][2];
#pragma unroll
    for (int a = 0; a < 2; ++a)
#pragma unroll
        for (int b = 0; b < 2; ++b)
#pragma unroll
            for (int m = 0; m < 4; ++m)
#pragma unroll
                for (int n = 0; n < 2; ++n) acc[a][b][m][n] = (f32x4){0.f, 0.f, 0.f, 0.f};
    bf16x8 At[4][2], B0[2][2], B1[2][2];
    const char* cA = (const char*)g.A + (size_t)cur.pm * tstepA; const char* cB = (const char*)g.Bt + (size_t)cur.pn * tstep;
    S.a_ready(cur);
    if constexpr (SP2) {
        PG8_STAGE(PG8_SB(0, 0), cB, voffB); PG8_STAGE(PG8_SB(0, 1), cB + hstep, voffB); PG8_STAGE(PG8_SA(0, 0), cA, voffA); PG8_STAGE(PG8_SA(0, 1), cA + hstepA, voffA);
        if (wr == 1) PG8_BAR;
        PG8_WAIT_V(2); PG8_BAR;
        PG8_STAGE(PG8_SB(1, 0), cB + kstep, voffB); PG8_STAGE(PG8_SA(1, 0), cA + kstep, voffA); PG8_STAGE(PG8_SB(1, 1), cB + hstep + kstep, voffB);
        PG8_WAIT_V(6); PG8_BAR;
    } else {
        PG8_STAGE(PG8_SB(0, 0), cB, voffB); PG8_STAGE(PG8_SA(0, 0), cA, voffA); PG8_STAGE(PG8_SB(0, 1), cB + hstep, voffB); PG8_STAGE(PG8_SA(0, 1), cA + hstepA, voffA);
        if (wr == 1) PG8_BAR;
        PG8_WAIT_V(4); PG8_BAR;
        PG8_STAGE(PG8_SB(1, 0), cB + kstep, voffB); PG8_STAGE(PG8_SA(1, 0), cA + kstep, voffA); PG8_STAGE(PG8_SB(1, 1), cB + hstep + kstep, voffB);
        PG8_WAIT_V(6); PG8_BAR;
    }
    for (;;) {
        const bool has_next = S.next(ui + 1, nxt);
        const char* nA = has_next ? (const char*)g.A + (size_t)nxt.pm * tstepA : cA; const char* nB = has_next ? (const char*)g.Bt + (size_t)nxt.pn * tstep : cB;
        for (int t = 0; t < nt; t += 2) {
            const bool last = (t == nt - 2);
            const char* a1 = cA + (size_t)(t + 1) * kstep;
            const char* a2 = last ? nA : cA + (size_t)(t + 2) * kstep; const char* b2 = last ? nB : cB + (size_t)(t + 2) * kstep;
            const char* a3 = a2 + kstep; const char* b3 = b2 + kstep;
            if (last && has_next) S.a_ready(nxt);
            if constexpr (SP2) {
            PG8_LDB(B0, 0, 0); PG8_LDB(B1, 0, 1); PG8_SCHED; PG8_LDA(At, 0, 0); PG8_STAGE(PG8_SA(1, 1), a1 + hstepA, voffA);
            PG8_WAIT_V(8); PG8_WAIT_L(0); PG8_BAR; PG8_MMA(0, 0, At, B0); PG8_MMA(0, 1, At, B1); PG8_BAR; PG8_SCHED;
            PG8_LDA(At, 0, 1); PG8_STAGE(PG8_SB(0, 0), b2, voffB); PG8_STAGE(PG8_SB(0, 1), b2 + hstep, voffB); PG8_STAGE(PG8_SA(0, 0), a2, voffA);
            PG8_WAIT_V(8); PG8_WAIT_L(0); PG8_BAR; PG8_MMA(1, 0, At, B0); PG8_MMA(1, 1, At, B1); PG8_BAR; PG8_SCHED;
            PG8_LDB(B0, 1, 0); PG8_LDB(B1, 1, 1); PG8_SCHED; PG8_LDA(At, 1, 0); PG8_STAGE(PG8_SA(0, 1), a2 + hstepA, voffA);
            PG8_WAIT_V(8); PG8_WAIT_L(0); PG8_BAR; PG8_MMA(0, 0, At, B0); PG8_MMA(0, 1, At, B1); PG8_BAR; PG8_SCHED;
            PG8_LDA(At, 1, 1); PG8_STAGE(PG8_SB(1, 0), b3, voffB); PG8_STAGE(PG8_SB(1, 1), b3 + hstep, voffB); PG8_STAGE(PG8_SA(1, 0), a3, voffA);
            PG8_WAIT_V(8); PG8_WAIT_L(0); PG8_BAR; PG8_MMA(1, 0, At, B0); PG8_MMA(1, 1, At, B1); PG8_BAR; PG8_SCHED;
            } else {
            PG8_LDB(B0, 0, 0); PG8_SCHED; PG8_LDA(At, 0, 0); PG8_STAGE(PG8_SA(1, 1), a1 + hstepA, voffA);
            PG8_WAIT_L(8); PG8_BAR; PG8_WAIT_L(0); PG8_MMA(0, 0, At, B0); PG8_BAR; PG8_SCHED;
            PG8_LDB(B1, 0, 1); PG8_STAGE(PG8_SB(0, 0), b2, voffB);
            PG8_BAR; PG8_WAIT_L(0); PG8_MMA(0, 1, At, B1); PG8_BAR;
            PG8_LDA(At, 0, 1); PG8_STAGE(PG8_SA(0, 0), a2, voffA);
            PG8_BAR; PG8_WAIT_L(0); PG8_MMA(1, 0, At, B0); PG8_BAR; PG8_SCHED;
            PG8_STAGE(PG8_SB(0, 1), b2 + hstep, voffB);
            PG8_WAIT_V(6); PG8_BAR; PG8_MMA(1, 1, At, B1); PG8_BAR;
            PG8_LDB(B0, 1, 0); PG8_SCHED; PG8_LDA(At, 1, 0); PG8_STAGE(PG8_SA(0, 1), a2 + hstepA, voffA);
            PG8_WAIT_L(8); PG8_BAR; PG8_WAIT_L(0); PG8_MMA(0, 0, At, B0); PG8_BAR; PG8_SCHED;
            PG8_LDB(B1, 1, 1); PG8_STAGE(PG8_SB(1, 0), b3, voffB);
            PG8_BAR; PG8_WAIT_L(0); PG8_MMA(0, 1, At, B1); PG8_BAR;
            PG8_LDA(At, 1, 1); PG8_STAGE(PG8_SA(1, 0), a3, voffA);
            PG8_BAR; PG8_WAIT_L(0); PG8_MMA(1, 0, At, B0); PG8_BAR; PG8_SCHED;
            PG8_STAGE(PG8_SB(1, 1), b3 + hstep, voffB);
            PG8_WAIT_V(6); PG8_BAR; PG8_MMA(1, 1, At, B1); PG8_BAR;
            }
        }
        if constexpr (ALIGN_EPI) { if (wr == 0) PG8_BAR; }
        if constexpr (!Epi::AFTER_DRAIN) { int t2_ = threadIdx.x; asm volatile("" : "+v"(t2_)); E(acc, cur, wr, wc, t2_ & 15, (t2_ & 63) >> 4); S.done(cur); }
        if (!has_next) break;
#pragma unroll
        for (int a = 0; a < 2; ++a)
#pragma unroll
            for (int b = 0; b < 2; ++b)
#pragma unroll
                for (int m = 0; m < 4; ++m)
#pragma unroll
                    for (int n = 0; n < 2; ++n) acc[a][b][m][n] = (f32x4){0.f, 0.f, 0.f, 0.f};
        cur = nxt; cA = nA; cB = nB; ++ui;
        if constexpr (ALIGN_EPI) { if (wr == 1) PG8_BAR; }
    }
    PG8_WAIT_V(0);
    if constexpr (!ALIGN_EPI) { if (wr == 0) PG8_BAR; }
    PG8_BAR;
    if constexpr (Epi::AFTER_DRAIN) { E.fused(acc, cur, wr, wc, fr, fq, lds, wid, lane); S.done(cur); }
#undef PG8_SA
#undef PG8_SB
#undef PG8_STAGE
#undef PG8_LDA
#undef PG8_LDB
#undef PG8_MMA
#undef PG8_WAIT_V
#undef PG8_WAIT_L
#undef PG8_BAR
#undef PG8_SCHED
}
}
namespace pg8 {
constexpr size_t KB_OFF = (size_t)373 << 20, VB_OFF = (size_t)380 << 20, ROPE_OFF = 64 * 1024, SK_OFF = (size_t)12288 * 2048, SV_OFF = SK_OFF + 16 * 2 * 256 * 256;
typedef unsigned u32x2e __attribute__((ext_vector_type(2)));
__device__ __forceinline__ float e_lo(unsigned u) { return __uint_as_float(u << 16); }
__device__ __forceinline__ float e_hi(unsigned u) { return __uint_as_float(u & 0xffff0000u); }
__device__ __forceinline__ float e_sig(float x) { return fminf(__expf(-x), 1e30f); }
struct EpiProj {
    static constexpr bool PERM = true, AFTER_DRAIN = false;
    bf16_t* proj; bf16_t* gates; const float* bmerge; int skip; int pn_off;
    unsigned char* ws; float* out; const float* qnw; const float* knw; int l; PG8_LAS float* red;
    __device__ __forceinline__ void head_tiles(const f32x4 (&acc)[2][2][4][2], const Unit& u, int pnn, int wr, int wc, int fr, int fq) const {
        const int rowt = u.pm * BM; const bool lat = rowt >= 4096;
        const int bb = lat ? ((rowt - 4096) >> 11) : (rowt >> 8);
        const int t0 = lat ? ((rowt - 4096) & 2047) : 0;
        const size_t kv0 = lat ? (size_t)4096 + (size_t)bb * 2304 + t0 : (size_t)rowt;
        bf16_t* KB = (bf16_t*)(ws + KB_OFF); bf16_t* VB = (bf16_t*)(ws + VB_OFF);
        if (pnn == 5) {
#pragma unroll
            for (int ai = 0; ai < 2; ++ai)
#pragma unroll
                for (int m = 0; m < 4; ++m) { const int rl = ai * HALF + wr * 64 + m * 16 + fr;
#pragma unroll
                    for (int bj = 0; bj < 2; ++bj) { const int c = bj * HALF + wc * 32 + 8 * fq; const f32x4 v0 = acc[ai][bj][m][0], v1 = acc[ai][bj][m][1];
                        u32x4 w; w.x = cvt_pk_bf16(v0[0], v0[1]); w.y = cvt_pk_bf16(v0[2], v0[3]); w.z = cvt_pk_bf16(v1[0], v1[1]); w.w = cvt_pk_bf16(v1[2], v1[3]);
                        *(u32x4*)(VB + (kv0 + rl) * 256 + c) = w;
                        if (!lat) { float* sv = out + SV_OFF + ((size_t)(bb * 2 + l) * 256 + rl) * 256 + c; *(f32x4*)sv = v0; *(f32x4*)(sv + 4) = v1; } } }
            return; }
        const bool isk = pnn == 4; const float* nw = isk ? knw : qnw;
#pragma unroll
        for (int ai = 0; ai < 2; ++ai)
#pragma unroll
            for (int m = 0; m < 4; ++m) { const int rl = ai * HALF + wr * 64 + m * 16 + fr;
#pragma unroll
                for (int bj = 0; bj < 2; ++bj) { const f32x4 a = acc[ai][bj][m][0], b = acc[ai][bj][m][1];
                    float ss = (a[0] * a[0] + a[1] * a[1]) + (a[2] * a[2] + a[3] * a[3]) + (b[0] * b[0] + b[1] * b[1]) + (b[2] * b[2] + b[3] * b[3]);
                    ss += __shfl_xor(ss, 16); ss += __shfl_xor(ss, 32);
                    if (fq == 0) red[(rl * 2 + bj) * 4 + wc] = ss; } }
        asm volatile("s_waitcnt lgkmcnt(0)" ::: "memory"); __builtin_amdgcn_s_barrier(); asm volatile("" ::: "memory");
        const int q0 = 4 * (4 * wc + fq), base = q0 < 32 ? q0 : q0 + 32;
        const f32x4 w0 = *(const f32x4*)(nw + base), w1 = *(const f32x4*)(nw + base + 32);
        const float* tab = (const float*)(ws + ROPE_OFF);
#pragma unroll
        for (int ai = 0; ai < 2; ++ai)
#pragma unroll
            for (int m = 0; m < 4; ++m) { const int rl = ai * HALF + wr * 64 + m * 16 + fr; const int t = t0 + rl;
                f32x4 cs = {1.f, 1.f, 1.f, 1.f}, sn = {0.f, 0.f, 0.f, 0.f};
                if (lat) { const int pos = q0 < 32 ? (t >> 6) : (t & 63); const float* tp = tab + (size_t)(pos * 32 + (q0 & 31)) * 2;
                    const f32x4 c0 = *(const f32x4*)tp, c1 = *(const f32x4*)(tp + 4); cs = (f32x4){c0[0], c0[2], c1[0], c1[2]}; sn = (f32x4){c0[1], c0[3], c1[1], c1[3]}; }
#pragma unroll
                for (int bj = 0; bj < 2; ++bj) { const f32x4 pr = *(const PG8_LAS f32x4*)(red + (rl * 2 + bj) * 4);
                    const float rstd = 1.f / sqrtf(((pr[0] + pr[1]) + (pr[2] + pr[3])) * (1.f / 128.f) + 1e-6f);
                    f32x4 y0 = acc[ai][bj][m][0] * rstd * w0, y1 = acc[ai][bj][m][1] * rstd * w1;
                    const int hc = bj * HALF + wc * 32 + 8 * fq;
                    if (isk && !lat) { float* sk = out + SK_OFF + ((size_t)(bb * 2 + l) * 256 + rl) * 256 + bj * HALF + base; *(f32x4*)sk = y0; *(f32x4*)(sk + 32) = y1; }
                    const f32x4 o0 = y0 * cs - y1 * sn, o1 = y1 * cs + y0 * sn;
                    u32x4 w; w.x = cvt_pk_bf16(o0[0], o0[1]); w.y = cvt_pk_bf16(o0[2], o0[3]); w.z = cvt_pk_bf16(o1[0], o1[1]); w.w = cvt_pk_bf16(o1[2], o1[3]);
                    if (isk) *(u32x4*)(KB + (kv0 + rl) * 256 + hc) = w;
                    else *(u32x4*)(proj + (size_t)(rowt + rl) * 5120 + pnn * BM + hc) = w; } }
        asm volatile("s_waitcnt lgkmcnt(0)" ::: "memory"); __builtin_amdgcn_s_barrier(); asm volatile("" ::: "memory");
    }
    __device__ __forceinline__ void operator()(const f32x4 (&acc)[2][2][4][2], const Unit& u, int wr, int wc, int fr, int fq) const {
        if (skip) return;
        const int pnn = u.pn + pn_off; const int row0 = u.pm * BM + wr * 64 + fr; const bool isg = pnn >= 20;
        if (pnn < 6) { head_tiles(acc, u, pnn, wr, wc, fr, fq); return; }
        const int colt = (isg ? pnn - 20 : pnn) * BM; const int ld = isg ? 6144 : 5120; bf16_t* base = isg ? gates : proj;
        const int col0 = colt + wc * 32 + 8 * fq;
        f32x4 bv[2][2];
#pragma unroll
        for (int bj = 0; bj < 2; ++bj)
#pragma unroll
            for (int n = 0; n < 2; ++n) bv[bj][n] = isg ? *(const f32x4*)(bmerge + col0 + bj * HALF + 4 * n) : (f32x4){0.f, 0.f, 0.f, 0.f};
#pragma unroll
        for (int ai = 0; ai < 2; ++ai)
#pragma unroll
            for (int m = 0; m < 4; ++m) { bf16_t* rowp = base + (size_t)(row0 + ai * HALF + m * 16) * ld + col0;
                bf16_t* fragp = gates + ((((size_t)u.pm * 24 + (pnn - 20)) * 16 + (ai * 8 + m * 2)) * 512 + ((wr * 4 + wc) * 64 + fq * 16 + fr)) * 8;
#pragma unroll
                for (int bj = 0; bj < 2; ++bj) { f32x4 v0 = acc[ai][bj][m][0] + bv[bj][0], v1 = acc[ai][bj][m][1] + bv[bj][1];
                    if (isg) { v0 = (f32x4){e_sig(v0[0]), e_sig(v0[1]), e_sig(v0[2]), e_sig(v0[3])}; v1 = (f32x4){e_sig(v1[0]), e_sig(v1[1]), e_sig(v1[2]), e_sig(v1[3])}; }
                    u32x4 w; w.x = cvt_pk_bf16(v0[0], v0[1]); w.y = cvt_pk_bf16(v0[2], v0[3]); w.z = cvt_pk_bf16(v1[0], v1[1]); w.w = cvt_pk_bf16(v1[2], v1[3]);
                    if (isg) __builtin_nontemporal_store(w, (u32x4*)(fragp + bj * 4096)); else __builtin_nontemporal_store(w, (u32x4*)(rowp + bj * HALF)); } }
    }
};
struct EpiBranch {
    static constexpr bool PERM = true, AFTER_DRAIN = false;
    bf16_t* merged; const bf16_t* gates; int first;
    __device__ __forceinline__ void operator()(const f32x4 (&acc)[2][2][4][2], const Unit& u, int wr, int wc, int fr, int fq) const {
        const int row0 = u.pm * BM + wr * 64 + fr; const int col0 = u.pn * BM + wc * 32 + 8 * fq;
#pragma unroll
        for (int ai = 0; ai < 2; ++ai)
#pragma unroll
            for (int m = 0; m < 4; ++m) { const size_t row = (size_t)(row0 + ai * HALF + m * 16);
#pragma unroll
                for (int bj = 0; bj < 2; ++bj) { const u32x4 g = *(const u32x4*)(gates + row * 6144 + col0 + bj * HALF); bf16_t* mp = merged + row * 2048 + col0 + bj * HALF;
                    f32x4 v0 = acc[ai][bj][m][0], v1 = acc[ai][bj][m][1];
                    v0 = v0 * (f32x4){e_lo(g.x), e_hi(g.x), e_lo(g.y), e_hi(g.y)}; v1 = v1 * (f32x4){e_lo(g.z), e_hi(g.z), e_lo(g.w), e_hi(g.w)};
                    if (!first) { const u32x4 o = *(const u32x4*)mp; v0 = v0 + (f32x4){e_lo(o.x), e_hi(o.x), e_lo(o.y), e_hi(o.y)}; v1 = v1 + (f32x4){e_lo(o.z), e_hi(o.z), e_lo(o.w), e_hi(o.w)}; }
                    u32x4 w; w.x = cvt_pk_bf16(v0[0], v0[1]); w.y = cvt_pk_bf16(v0[2], v0[3]); w.z = cvt_pk_bf16(v1[0], v1[1]); w.w = cvt_pk_bf16(v1[2], v1[3]);
                    *(u32x4*)mp = w; } }
    }
};
struct EpiResid {
    static constexpr bool PERM = false, AFTER_DRAIN = false;
    const float* xc; const float* xl; float* out; const float* mod;
    __device__ __forceinline__ void operator()(const f32x4 (&acc)[2][2][4][2], const Unit& u, int wr, int wc, int fr, int fq) const {
        const int rowt = u.pm * BM; const int col0 = u.pn * BM + wc * 32 + 4 * fq;
        const float* gate = mod + ((rowt < 4096) ? 0 : 1 + ((rowt - 4096) >> 11)) * 6144 + 4096;
        const float* xo = (rowt < 4096) ? xc : xl - (size_t)4096 * 2048;
        f32x4 gv[2][2];
#pragma unroll
        for (int bj = 0; bj < 2; ++bj)
#pragma unroll
            for (int n = 0; n < 2; ++n) gv[bj][n] = *(const f32x4*)(gate + col0 + bj * HALF + n * 16);
#pragma unroll
        for (int ai = 0; ai < 2; ++ai)
#pragma unroll
            for (int m = 0; m < 4; ++m) { const size_t off = (size_t)(rowt + ai * HALF + wr * 64 + m * 16 + fr) * 2048 + col0;
#pragma unroll
                for (int bj = 0; bj < 2; ++bj)
#pragma unroll
                    for (int n = 0; n < 2; ++n) { const f32x4 xv = *(const f32x4*)(xo + off + bj * HALF + n * 16);
                        *(f32x4*)(out + off + bj * HALF + n * 16) = xv + gv[bj][n] * acc[ai][bj][m][n]; } }
    }
};
struct DeferOrder {
    int G, c;
    __device__ __forceinline__ bool next(int i, Unit& u) const {
        if (G == 256) { const int x = c & 7, j = (c >> 3) + 32 * i; if (j >= 40) return false;
            u.pm = 5 * x + (j >> 3); u.pn = j & 7; u.type = 0; return true; }
        const long t = (long)i * G + c; if (t >= 320) return false; u.pm = (int)(t >> 3); u.pn = (int)(t & 7); u.type = 0; return true; }
    __device__ __forceinline__ void a_ready(const Unit&) const {}
    __device__ __forceinline__ void done(const Unit&) const {}
};
struct Gemm1Order {
    StaticOrder so; int G, c;
    __device__ __forceinline__ void init(int M, int N, int G_, int c_) { so.init(M, N, G_, c_); G = G_; c = c_; }
    __device__ __forceinline__ bool next(int i, Unit& u) const { const long L = (long)i * G + c; if (L < so.nwg) return so.next(i, u); const long e = L - so.nwg; if (e >= 64) return false;
        u.pm = 40 + (int)(e >> 3); u.pn = 36 + (int)(e & 7); u.type = 0; return true; }
    __device__ __forceinline__ void a_ready(const Unit&) const {}
    __device__ __forceinline__ void done(const Unit&) const {}
};
}
namespace pg8 {
struct Gemm2 { const bf16_t* A0; const bf16_t* B0; const bf16_t* A1; const bf16_t* B1; int M, N, K, lda; };
template <class Epi, class Sched, bool ALIGN_EPI = false, bool SP2 = false>
__device__ __forceinline__ void gemm_fused(PG8_LAS unsigned char* lds, const Gemm2 g, const Sched& S, const Epi& E) {
    int tid_ = threadIdx.x; asm volatile("" : "+v"(tid_)); const int tid = tid_, wid = __builtin_amdgcn_readfirstlane(tid >> 6), lane = tid & 63, wr = wid >> 2, wc = wid & 3, fr = lane & 15, fq = lane >> 4;
    const int K = g.K, nt = K / BK;
    unsigned voffA[2], voffB[2];
#pragma unroll
    for (int i = 0; i < 2; ++i) { int R, C; stage_rc(tid * 16 + i * 8192, R, C); const int Rb = Epi::PERM ? ((R & ~31) + perm32(R & 31)) : R;
        voffA[i] = (unsigned)(R * g.lda + C) * 2u; voffB[i] = (unsigned)(Rb * K + C) * 2u; }
    const size_t kstep = (size_t)(BK * 2);
    const size_t hstep = (size_t)HALF * K * 2;
    const size_t tstep = 2 * hstep; const size_t hstepA = (size_t)HALF * g.lda * 2, tstepA = 2 * hstepA;
    const unsigned ldsw = (unsigned)wid * 1024u;
    const int aoff = lds_byte(wr * 64 + fr, fq * 8), boff = lds_byte(wc * 32 + fr, fq * 8);
#define PG8_SA(b, h) (((b) * 2 + (h)) * HTB)
#define PG8_SB(b, h) ((4 + (b) * 2 + (h)) * HTB)
#define PG8_STAGE(bufoff, gbase, voff) do { _Pragma("unroll") for (int _i = 0; _i < 2; ++_i) \
        __builtin_amdgcn_global_load_lds((const unsigned*)((const char*)(gbase) + (voff)[_i]), (PG8_LAS unsigned*)(lds + (bufoff) + ldsw + _i * 8192), 16, 0, 0); } while (0)
#define PG8_LDA(dst, b, h) do { _Pragma("unroll") for (int m = 0; m < 4; ++m) _Pragma("unroll") for (int k = 0; k < 2; ++k) dst[m][k] = *(const PG8_LAS bf16x8*)(lds + PG8_SA(b, h) + aoff + m * 2048 + k * 1024); } while (0)
#define PG8_LDB(dst, b, h) do { _Pragma("unroll") for (int n = 0; n < 2; ++n) _Pragma("unroll") for (int k = 0; k < 2; ++k) dst[n][k] = *(const PG8_LAS bf16x8*)(lds + PG8_SB(b, h) + boff + n * 2048 + k * 1024); } while (0)
#define PG8_MMA(ai, bj, At, Bt) do { __builtin_amdgcn_s_setprio(1); _Pragma("unroll") for (int m = 0; m < 4; ++m) _Pragma("unroll") for (int n = 0; n < 2; ++n) _Pragma("unroll") for (int k = 0; k < 2; ++k) \
        acc[ai][bj][m][n] = __builtin_amdgcn_mfma_f32_16x16x32_bf16(Bt[n][k], At[m][k], acc[ai][bj][m][n], 0, 0, 0); __builtin_amdgcn_s_setprio(0); } while (0)
#define PG8_WAIT_V(n) asm volatile("s_waitcnt vmcnt(" #n ")" ::: "memory")
#define PG8_WAIT_L(n) asm volatile("s_waitcnt lgkmcnt(" #n ")" ::: "memory")
#define PG8_BAR __builtin_amdgcn_s_barrier()
#define PG8_SCHED __builtin_amdgcn_sched_barrier(0)
    Unit cur, nxt; int ui = 0;
    if (!S.next(0, cur)) return;
    f32x4 acc[2][2][4][2];
#pragma unroll
    for (int a = 0; a < 2; ++a)
#pragma unroll
        for (int b = 0; b < 2; ++b)
#pragma unroll
            for (int m = 0; m < 4; ++m)
#pragma unroll
                for (int n = 0; n < 2; ++n) acc[a][b][m][n] = (f32x4){0.f, 0.f, 0.f, 0.f};
    bf16x8 At[4][2], B0[2][2], B1[2][2];
    const char* cA = (const char*)(cur.type ? g.A1 : g.A0) + (size_t)cur.pm * tstepA; const char* cB = (const char*)(cur.type ? g.B1 : g.B0) + (size_t)cur.pn * tstep;
    S.a_ready(cur);
    if constexpr (SP2) {
        PG8_STAGE(PG8_SB(0, 0), cB, voffB); PG8_STAGE(PG8_SB(0, 1), cB + hstep, voffB); PG8_STAGE(PG8_SA(0, 0), cA, voffA); PG8_STAGE(PG8_SA(0, 1), cA + hstepA, voffA);
        if (wr == 1) PG8_BAR;
        PG8_WAIT_V(2); PG8_BAR;
        PG8_STAGE(PG8_SB(1, 0), cB + kstep, voffB); PG8_STAGE(PG8_SA(1, 0), cA + kstep, voffA); PG8_STAGE(PG8_SB(1, 1), cB + hstep + kstep, voffB);
        PG8_WAIT_V(6); PG8_BAR;
    } else {
        PG8_STAGE(PG8_SB(0, 0), cB, voffB); PG8_STAGE(PG8_SA(0, 0), cA, voffA); PG8_STAGE(PG8_SB(0, 1), cB + hstep, voffB); PG8_STAGE(PG8_SA(0, 1), cA + hstepA, voffA);
        if (wr == 1) PG8_BAR;
        PG8_WAIT_V(4); PG8_BAR;
        PG8_STAGE(PG8_SB(1, 0), cB + kstep, voffB); PG8_STAGE(PG8_SA(1, 0), cA + kstep, voffA); PG8_STAGE(PG8_SB(1, 1), cB + hstep + kstep, voffB);
        PG8_WAIT_V(6); PG8_BAR;
    }
    for (;;) {
        const bool has_next = S.next(ui + 1, nxt);
        const char* nA = has_next ? (const char*)(nxt.type ? g.A1 : g.A0) + (size_t)nxt.pm * tstepA : cA; const char* nB = has_next ? (const char*)(nxt.type ? g.B1 : g.B0) + (size_t)nxt.pn * tstep : cB;
        for (int t = 0; t < nt; t += 2) {
            const bool last = (t == nt - 2);
            const char* a1 = cA + (size_t)(t + 1) * kstep;
            const char* a2 = last ? nA : cA + (size_t)(t + 2) * kstep; const char* b2 = last ? nB : cB + (size_t)(t + 2) * kstep;
            const char* a3 = a2 + kstep; const char* b3 = b2 + kstep;
            if (last && has_next) S.a_ready(nxt);
            if constexpr (SP2) {
            PG8_LDB(B0, 0, 0); PG8_LDB(B1, 0, 1); PG8_SCHED; PG8_LDA(At, 0, 0); PG8_STAGE(PG8_SA(1, 1), a1 + hstepA, voffA);
            PG8_WAIT_V(8); PG8_WAIT_L(0); PG8_BAR; PG8_MMA(0, 0, At, B0); PG8_MMA(0, 1, At, B1); PG8_BAR; PG8_SCHED;
            PG8_LDA(At, 0, 1); PG8_STAGE(PG8_SB(0, 0), b2, voffB); PG8_STAGE(PG8_SB(0, 1), b2 + hstep, voffB); PG8_STAGE(PG8_SA(0, 0), a2, voffA);
            PG8_WAIT_V(8); PG8_WAIT_L(0); PG8_BAR; PG8_MMA(1, 0, At, B0); PG8_MMA(1, 1, At, B1); PG8_BAR; PG8_SCHED;
            PG8_LDB(B0, 1, 0); PG8_LDB(B1, 1, 1); PG8_SCHED; PG8_LDA(At, 1, 0); PG8_STAGE(PG8_SA(0, 1), a2 + hstepA, voffA);
            PG8_WAIT_V(8); PG8_WAIT_L(0); PG8_BAR; PG8_MMA(0, 0, At, B0); PG8_MMA(0, 1, At, B1); PG8_BAR; PG8_SCHED;
            PG8_LDA(At, 1, 1); PG8_STAGE(PG8_SB(1, 0), b3, voffB); PG8_STAGE(PG8_SB(1, 1), b3 + hstep, voffB); PG8_STAGE(PG8_SA(1, 0), a3, voffA);
            PG8_WAIT_V(8); PG8_WAIT_L(0); PG8_BAR; PG8_MMA(1, 0, At, B0); PG8_MMA(1, 1, At, B1); PG8_BAR; PG8_SCHED;
            } else {
            PG8_LDB(B0, 0, 0); PG8_SCHED; PG8_LDA(At, 0, 0); PG8_STAGE(PG8_SA(1, 1), a1 + hstepA, voffA);
            PG8_WAIT_L(8); PG8_BAR; PG8_WAIT_L(0); PG8_MMA(0, 0, At, B0); PG8_BAR; PG8_SCHED;
            PG8_LDB(B1, 0, 1); PG8_STAGE(PG8_SB(0, 0), b2, voffB);
            PG8_BAR; PG8_WAIT_L(0); PG8_MMA(0, 1, At, B1); PG8_BAR;
            PG8_LDA(At, 0, 1); PG8_STAGE(PG8_SA(0, 0), a2, voffA);
            PG8_BAR; PG8_WAIT_L(0); PG8_MMA(1, 0, At, B0); PG8_BAR; PG8_SCHED;
            PG8_STAGE(PG8_SB(0, 1), b2 + hstep, voffB);
            PG8_WAIT_V(6); PG8_BAR; PG8_MMA(1, 1, At, B1); PG8_BAR;
            PG8_LDB(B0, 1, 0); PG8_SCHED; PG8_LDA(At, 1, 0); PG8_STAGE(PG8_SA(0, 1), a2 + hstepA, voffA);
            PG8_WAIT_L(8); PG8_BAR; PG8_WAIT_L(0); PG8_MMA(0, 0, At, B0); PG8_BAR; PG8_SCHED;
            PG8_LDB(B1, 1, 1); PG8_STAGE(PG8_SB(1, 0), b3, voffB);
            PG8_BAR; PG8_WAIT_L(0); PG8_MMA(0, 1, At, B1); PG8_BAR;
            PG8_LDA(At, 1, 1); PG8_STAGE(PG8_SA(1, 0), a3, voffA);
            PG8_BAR; PG8_WAIT_L(0); PG8_MMA(1, 0, At, B0); PG8_BAR; PG8_SCHED;
            PG8_STAGE(PG8_SB(1, 1), b3 + hstep, voffB);
            PG8_WAIT_V(6); PG8_BAR; PG8_MMA(1, 1, At, B1); PG8_BAR;
            }
            if (cur.type == 0 && (t == 14 || t == 22)) { int t3_ = threadIdx.x; asm volatile("" : "+v"(t3_)); E.mid(acc, cur, wr, wc, t3_ & 15, (t3_ & 63) >> 4, t == 14 ? 0 : 1); }
        }
        if constexpr (ALIGN_EPI) { if (wr == 0) PG8_BAR; }
        if constexpr (!Epi::AFTER_DRAIN) { int t2_ = threadIdx.x; asm volatile("" : "+v"(t2_)); E(acc, cur, wr, wc, t2_ & 15, (t2_ & 63) >> 4); S.done(cur); }
        if (!has_next) break;
#pragma unroll
        for (int a = 0; a < 2; ++a)
#pragma unroll
            for (int b = 0; b < 2; ++b)
#pragma unroll
                for (int m = 0; m < 4; ++m)
#pragma unroll
                    for (int n = 0; n < 2; ++n) acc[a][b][m][n] = (f32x4){0.f, 0.f, 0.f, 0.f};
        cur = nxt; cA = nA; cB = nB; ++ui;
        if constexpr (ALIGN_EPI) { if (wr == 1) PG8_BAR; }
    }
    PG8_WAIT_V(0);
    if constexpr (!ALIGN_EPI) { if (wr == 0) PG8_BAR; }
    PG8_BAR;
    if constexpr (Epi::AFTER_DRAIN) { E.fused(acc, cur, wr, wc, fr, fq, lds, wid, lane); S.done(cur); }
#undef PG8_SA
#undef PG8_SB
#undef PG8_STAGE
#undef PG8_LDA
#undef PG8_LDB
#undef PG8_MMA
#undef PG8_WAIT_V
#undef PG8_WAIT_L
#undef PG8_BAR
#undef PG8_SCHED
}
}
namespace pg8 {
__device__ __forceinline__ void store16_sc1(void* p, u32x4 v) { asm volatile("global_store_dwordx4 %0, %1, off sc1" :: "v"(p), "v"(v) : "memory"); }
#ifndef MK_WT
#define MK_WT 1
#endif
#if MK_WT
#define MK_ST16(p, v) store16_sc1((p), (v))
#define MK_PUBLISH_FENCE do {} while (0)
#else
#define MK_ST16(p, v) (*(u32x4*)(p) = (v))
#define MK_PUBLISH_FENCE __builtin_amdgcn_fence(__ATOMIC_RELEASE, "agent")
#endif
struct FusedOrder {
    int G, c; unsigned* cnt;
    __device__ __forceinline__ bool next(int i, Unit& u) const {
        if (G == 256) { if (i >= 3) return false; const int h = c >> 7, idx = c & 127, x = idx & 7, j = idx >> 3;
            u.type = (i == 0) ? 0 : (i == 1 ? h : 1);
            const int p0 = (i == 0) ? 16 * h : (i == 1 ? (h ? 0 : 32) : (h ? 32 : 16));
            u.pm = p0 + 4 * (x >> 1) + (j >> 2); u.pn = 4 * (x & 1) + (j & 3); return true; }
        const long L = (long)i * G + c; if (L >= 768) return false;
        u.type = L >= 384; const int t = (int)(L % 384); u.pm = t >> 3; u.pn = t & 7; return true;
    }
    __device__ __forceinline__ void a_ready(const Unit& u) const {
        if (u.type == 0) return;
        if (threadIdx.x < 64) {
            unsigned polls = 0;
            while ((unsigned)__builtin_amdgcn_readfirstlane(__hip_atomic_load(cnt + 64 * u.pm, __ATOMIC_RELAXED, __HIP_MEMORY_SCOPE_AGENT)) < 8u) {
                if (++polls > (1u << 20)) break;
                __builtin_amdgcn_s_sleep(2); }
            __builtin_amdgcn_fence(__ATOMIC_ACQUIRE, "agent");
            asm volatile("s_waitcnt vmcnt(0)" ::: "memory");
        }
        asm volatile("" ::: "memory"); __builtin_amdgcn_s_barrier(); asm volatile("" ::: "memory");
    }
    __device__ __forceinline__ void done(const Unit& u) const {
        if (u.type != 0) return;
        asm volatile("s_waitcnt vmcnt(0)" ::: "memory");
        __builtin_amdgcn_s_barrier(); asm volatile("" ::: "memory");
        if (threadIdx.x < 64) {
            __builtin_amdgcn_fence(__ATOMIC_RELEASE, "agent");
            asm volatile("s_waitcnt vmcnt(0)" ::: "memory");
            if (threadIdx.x == 0) __hip_atomic_fetch_add(cnt + 64 * u.pm, 1u, __ATOMIC_RELAXED, __HIP_MEMORY_SCOPE_AGENT);
        }
    }
};
struct EpiFused {
    static constexpr bool PERM = true, AFTER_DRAIN = false;
    unsigned char* ws; const float* xc; const float* xl; float* out; int l; size_t o_merged, o_gates, o_mod; int probe;
    __device__ __forceinline__ void mid(f32x4 (&acc)[2][2][4][2], const Unit& u, int wr, int wc, int fr, int fq, int br) const {
        const int tidf = (wr * 4 + wc) * 64 + fq * 16 + fr; const bf16_t* gates = (const bf16_t*)(ws + o_gates);
#pragma unroll
        for (int ai = 0; ai < 2; ++ai)
            {
                u32x4 a[4][2], b[4][2];
#pragma unroll
                for (int m = 0; m < 4; ++m) { const bf16_t* gp = gates + ((((size_t)u.pm * 24 + (br * 8 + u.pn)) * 16 + (ai * 8 + m * 2)) * 512 + tidf) * 8;
#pragma unroll
                    for (int bj = 0; bj < 2; ++bj) { a[m][bj] = *(const u32x4*)(gp + bj * 4096); b[m][bj] = *(const u32x4*)(gp + bj * 4096 + (size_t)8 * 16 * 512 * 8); } }
                __builtin_amdgcn_sched_barrier(0);
#pragma unroll
                for (int m = 0; m < 4; ++m)
#pragma unroll
                    for (int bj = 0; bj < 2; ++bj) { const u32x4 x = a[m][bj], y = b[m][bj];
                        acc[ai][bj][m][0] = acc[ai][bj][m][0] * (f32x4){(1.f + e_lo(y.x)) * __builtin_amdgcn_rcpf(1.f + e_lo(x.x)), (1.f + e_hi(y.x)) * __builtin_amdgcn_rcpf(1.f + e_hi(x.x)), (1.f + e_lo(y.y)) * __builtin_amdgcn_rcpf(1.f + e_lo(x.y)), (1.f + e_hi(y.y)) * __builtin_amdgcn_rcpf(1.f + e_hi(x.y))};
                        acc[ai][bj][m][1] = acc[ai][bj][m][1] * (f32x4){(1.f + e_lo(y.z)) * __builtin_amdgcn_rcpf(1.f + e_lo(x.z)), (1.f + e_hi(y.z)) * __builtin_amdgcn_rcpf(1.f + e_hi(x.z)), (1.f + e_lo(y.w)) * __builtin_amdgcn_rcpf(1.f + e_lo(x.w)), (1.f + e_hi(y.w)) * __builtin_amdgcn_rcpf(1.f + e_hi(x.w))}; }
                __builtin_amdgcn_sched_barrier(0);
            }
    }
    __device__ __forceinline__ void operator()(const f32x4 (&acc)[2][2][4][2], const Unit& u, int wr, int wc, int fr, int fq) const {
        const int rowt = u.pm * BM; const int row0 = rowt + wr * 64 + fr; const int col0 = u.pn * BM + wc * 32 + 8 * fq;
        if (u.type == 0) { const bf16_t* gates = (const bf16_t*)(ws + o_gates); bf16_t* merged = (bf16_t*)(ws + o_merged);
#pragma unroll
            for (int ai = 0; ai < 2; ++ai) { u32x4 g[4][2];
#pragma unroll
                for (int m = 0; m < 4; ++m)
#pragma unroll
                    for (int bj = 0; bj < 2; ++bj) g[m][bj] = *(const u32x4*)(gates + ((((size_t)u.pm * 24 + (16 + u.pn)) * 16 + (ai * 8 + m * 2 + bj)) * 512 + ((wr * 4 + wc) * 64 + fq * 16 + fr)) * 8);
                __builtin_amdgcn_sched_barrier(0);
#pragma unroll
                for (int m = 0; m < 4; ++m) { const size_t row = (size_t)(row0 + ai * HALF + m * 16);
#pragma unroll
                    for (int bj = 0; bj < 2; ++bj) { const u32x4 gg = g[m][bj];
                        const f32x4 v0 = acc[ai][bj][m][0] * (f32x4){__builtin_amdgcn_rcpf(1.f + e_lo(gg.x)), __builtin_amdgcn_rcpf(1.f + e_hi(gg.x)), __builtin_amdgcn_rcpf(1.f + e_lo(gg.y)), __builtin_amdgcn_rcpf(1.f + e_hi(gg.y))}, v1 = acc[ai][bj][m][1] * (f32x4){__builtin_amdgcn_rcpf(1.f + e_lo(gg.z)), __builtin_amdgcn_rcpf(1.f + e_hi(gg.z)), __builtin_amdgcn_rcpf(1.f + e_lo(gg.w)), __builtin_amdgcn_rcpf(1.f + e_hi(gg.w))};
                        u32x4 w; w.x = cvt_pk_bf16(v0[0], v0[1]); w.y = cvt_pk_bf16(v0[2], v0[3]); w.z = cvt_pk_bf16(v1[0], v1[1]); w.w = cvt_pk_bf16(v1[2], v1[3]);
                        *(u32x4*)(merged + row * 2048 + col0 + bj * HALF) = w; } }
                __builtin_amdgcn_sched_barrier(0); }
        } else {
            const float* mod = (const float*)(ws + o_mod) + (size_t)l * 5 * 6144; const float* gate = mod + ((rowt < 4096) ? 0 : 1 + ((rowt - 4096) >> 11)) * 6144 + 4096;
            const float* xo = (rowt < 4096) ? xc : xl - (size_t)4096 * 2048;
            f32x4 gv[2][2];
#pragma unroll
            for (int bj = 0; bj < 2; ++bj)
#pragma unroll
                for (int n = 0; n < 2; ++n) gv[bj][n] = *(const f32x4*)(gate + col0 + bj * HALF + 4 * n);
            unsigned ob1 = (unsigned)(row0 * 2048 + col0) * 4u; asm volatile("" : "+v"(ob1));
#pragma unroll
            for (int ai = 0; ai < 2; ++ai)
#pragma unroll
              for (int mh = 0; mh < 2; ++mh) {
                f32x4 xv[2][2][2];
#pragma unroll
                for (int m2 = 0; m2 < 2; ++m2) { const unsigned ob = ob1 + (unsigned)(ai * HALF + (mh * 2 + m2) * 16) * 8192u;
#pragma unroll
                    for (int bj = 0; bj < 2; ++bj)
#pragma unroll
                        for (int n = 0; n < 2; ++n) xv[m2][bj][n] = *(const f32x4*)((const char*)xo + (size_t)(ob + (unsigned)(bj * HALF + 4 * n) * 4u)); }
                __builtin_amdgcn_sched_barrier(0);
#pragma unroll
                for (int m2 = 0; m2 < 2; ++m2) { const int m = mh * 2 + m2; const unsigned ob = ob1 + (unsigned)(ai * HALF + m * 16) * 8192u;
#pragma unroll
                    for (int bj = 0; bj < 2; ++bj)
#pragma unroll
                        for (int n = 0; n < 2; ++n) { if (!probe) *(f32x4*)((char*)out + (size_t)(ob + (unsigned)(bj * HALF + 4 * n) * 4u)) = xv[m2][bj][n] + gv[bj][n] * acc[ai][bj][m][n]; } }
                asm volatile("" ::: "memory"); }
        }
    }
};
}
namespace att {
using bf16 = __hip_bfloat16;
constexpr int   D = 128, NW = 8, QBLK = 32, KVBLK = 64;
constexpr float SCALE = 0.088388347648318440f;
constexpr float THR = 8.f;
constexpr int SDEPTH = 2;
constexpr int LDQ = 5120, LDK = 256, LDO = 2048;
constexpr size_t SHM_V = KVBLK * D * 2, SHM_K = KVBLK * D * 2, SHM_ATTN = 2 * SHM_V + 2 * SHM_K + NW * 64 * 4;
constexpr int STG_OFF = (int)SHM_ATTN, STG_WAVE = 32 * 272;
using bf16x8 = __attribute__((ext_vector_type(8))) short;
using s16x4  = __attribute__((ext_vector_type(4))) short;
using f32x16 = __attribute__((ext_vector_type(16))) float;
using f32x8  = __attribute__((ext_vector_type(8))) float;
using u32x4  = __attribute__((ext_vector_type(4))) unsigned;
#define KSWZ(row, colB) ((row) * 256 + ((colB) ^ (((row) & 7) << 4)))
#define SBAR() __builtin_amdgcn_sched_barrier(0)
__device__ __forceinline__ int crow(int r, int hi) { return (r & 3) + 8 * (r >> 2) + 4 * hi; }
__device__ __forceinline__ unsigned cvtpk(float lo, float hi) {
  unsigned r; asm volatile("v_cvt_pk_bf16_f32 %0, %1, %2" : "=v"(r) : "v"(lo), "v"(hi)); return r;
}
template <typename TIn> struct Stage;
template <> struct Stage<bf16>  { using T = bf16x8;
  __device__ static __forceinline__ T ld8(const bf16* p) { return *reinterpret_cast<const bf16x8*>(p); }
  __device__ static __forceinline__ bf16x8 tobf(T x) { return x; } };
template <> struct Stage<float> { using T = f32x8;
  __device__ static __forceinline__ T ld8(const float* p) { return *reinterpret_cast<const f32x8*>(p); }
  __device__ static __forceinline__ bf16x8 tobf(T x) {
    u32x4 w = {cvtpk(x[0], x[1]), cvtpk(x[2], x[3]), cvtpk(x[4], x[5]), cvtpk(x[6], x[7])}; return *reinterpret_cast<bf16x8*>(&w); } };

__device__ __forceinline__ void partialSM(f32x16& p0, f32x16& p1, float& m_reg, float& mn, float& alpha) {
  constexpr float C = SCALE * 1.4426950408889634f;
  float pmax = p0[0]; for (int r = 1; r < 16; ++r) pmax = fmaxf(pmax, p0[r]); for (int r = 0; r < 16; ++r) pmax = fmaxf(pmax, p1[r]);
  { auto rr = __builtin_amdgcn_permlane32_swap(__float_as_uint(pmax), __float_as_uint(pmax), false, false);
    pmax = fmaxf(__uint_as_float(rr[0]), __uint_as_float(rr[1])); }
  if (__builtin_expect(__all(pmax - m_reg <= THR / SCALE), 1)) { mn = m_reg; alpha = 1.f; }
  else { mn = fmaxf(m_reg, pmax); alpha = __builtin_amdgcn_exp2f((m_reg - mn) * C); m_reg = mn; }
  float mnC = -mn * C;
  for (int r = 0; r < 16; ++r) p0[r] = fmaf(p0[r], C, mnC); for (int r = 0; r < 16; ++r) p1[r] = fmaf(p1[r], C, mnC);
  for (int r = 0; r < 16; ++r) p0[r] = __builtin_amdgcn_exp2f(p0[r]);
}
__device__ __forceinline__ void finishSM(f32x16& p0, f32x16& p1, float alpha, float& l_reg, bf16x8& pa0, bf16x8& pa1, bf16x8& pa2, bf16x8& pa3) {
  for (int r = 0; r < 16; ++r) p1[r] = __builtin_amdgcn_exp2f(p1[r]);
  float ps = 0; for (int r = 0; r < 16; ++r) ps += p0[r]; for (int r = 0; r < 16; ++r) ps += p1[r];
  { auto rr = __builtin_amdgcn_permlane32_swap(__float_as_uint(ps), __float_as_uint(ps), false, false);
    ps = __uint_as_float(rr[0]) + __uint_as_float(rr[1]); }
  l_reg = l_reg * alpha + ps;
#define PK4(P, BASE, OUT) do { unsigned a0 = cvtpk(P[BASE + 0], P[BASE + 1]), a1 = cvtpk(P[BASE + 2], P[BASE + 3]);   \
    unsigned b0 = cvtpk(P[BASE + 4], P[BASE + 5]), b1 = cvtpk(P[BASE + 6], P[BASE + 7]);                              \
    auto r0 = __builtin_amdgcn_permlane32_swap(a0, b0, false, false); auto r1 = __builtin_amdgcn_permlane32_swap(a1, b1, false, false); \
    u32x4 w = {r0[0], r1[0], r0[1], r1[1]}; OUT = *reinterpret_cast<bf16x8*>(&w); } while (0)
  PK4(p0, 0, pa0); PK4(p0, 8, pa1); PK4(p1, 0, pa2); PK4(p1, 8, pa3);
#undef PK4
}
__device__ __forceinline__ void qkt(f32x16& p0, f32x16& p1, const bf16* Ks, const bf16x8* qr, int r32, int hi) {
  p0 = f32x16{}; p1 = f32x16{};
  for (int d0 = 0; d0 < 8; ++d0) { int cb = (d0 * 16 + hi * 8) * 2;
    bf16x8 b0 = *reinterpret_cast<const bf16x8*>((const char*)Ks + KSWZ(r32, cb));
    bf16x8 b1 = *reinterpret_cast<const bf16x8*>((const char*)Ks + KSWZ(32 + r32, cb));
    p0 = __builtin_amdgcn_mfma_f32_32x32x16_bf16(b0, qr[d0], p0, 0, 0, 0);
    p1 = __builtin_amdgcn_mfma_f32_32x32x16_bf16(b1, qr[d0], p1, 0, 0, 0); }
}
__device__ __forceinline__ int v_st(int k, int c) { const int kk = (k & ~0xC) | ((k & 4) << 1) | ((k & 8) >> 1); return ((kk >> 3) * 4 + (c >> 5)) * 512 + ((kk & 7) * 32 + (c & 31)) * 2; }
__device__ __forceinline__ int v_rd_base(int lane) { return ((lane & 3) << 3) | (((lane >> 2) & 3) << 6) | (((lane >> 4) & 1) << 5) | (((lane >> 5) & 1) << 8); }
constexpr int v_rd_off(int d0, int ks, int half) { return d0 * 512 + ks * 4096 + half * 2048; }
template <int OFF> __device__ __forceinline__ s16x4 tr_read(int vb) {
  s16x4 r; asm volatile("ds_read_b64_tr_b16 %0, %1 offset:%2" : "=&v"(r) : "v"(vb), "i"(OFF) : "memory"); return r;
}
template <int D0> __device__ __forceinline__ void pv_one(f32x16& od, int vb, bf16x8 pa0, bf16x8 pa1, bf16x8 pa2, bf16x8 pa3) {
  const s16x4 l0 = tr_read<v_rd_off(D0, 0, 0)>(vb), h0 = tr_read<v_rd_off(D0, 0, 1)>(vb), l1 = tr_read<v_rd_off(D0, 1, 0)>(vb), h1 = tr_read<v_rd_off(D0, 1, 1)>(vb);
  const s16x4 l2 = tr_read<v_rd_off(D0, 2, 0)>(vb), h2 = tr_read<v_rd_off(D0, 2, 1)>(vb), l3 = tr_read<v_rd_off(D0, 3, 0)>(vb), h3 = tr_read<v_rd_off(D0, 3, 1)>(vb);
  asm volatile("s_waitcnt lgkmcnt(0)" ::: "memory"); SBAR();
#define PK(L, H) (bf16x8){L[0], L[1], L[2], L[3], H[0], H[1], H[2], H[3]}
  od = __builtin_amdgcn_mfma_f32_32x32x16_bf16(pa0, PK(l0, h0), od, 0, 0, 0);
  od = __builtin_amdgcn_mfma_f32_32x32x16_bf16(pa1, PK(l1, h1), od, 0, 0, 0);
  od = __builtin_amdgcn_mfma_f32_32x32x16_bf16(pa2, PK(l2, h2), od, 0, 0, 0);
  od = __builtin_amdgcn_mfma_f32_32x32x16_bf16(pa3, PK(l3, h3), od, 0, 0, 0);
#undef PK
}
__device__ __forceinline__ void pv_d0(f32x16* o, int vb, bf16x8 pa0, bf16x8 pa1, bf16x8 pa2, bf16x8 pa3) {
  pv_one<0>(o[0], vb, pa0, pa1, pa2, pa3); pv_one<1>(o[1], vb, pa0, pa1, pa2, pa3); pv_one<2>(o[2], vb, pa0, pa1, pa2, pa3); pv_one<3>(o[3], vb, pa0, pa1, pa2, pa3);
}

template <typename TQ>
__device__ __forceinline__ void attn_dense_body(const TQ* Qb, const bf16* __restrict__ Kh, const bf16* __restrict__ Vh,
                                                const bf16* __restrict__ Gb, bf16* __restrict__ Ob, int seq, char* lds) {
  using St = Stage<bf16>; using SQ = Stage<TQ>;
  int tid_ = threadIdx.x; asm volatile("" : "+v"(tid_)); const int tid = tid_, wid = __builtin_amdgcn_readfirstlane(tid >> 6), lane = tid & 63, r32 = lane & 31, hi = lane >> 5;
  bf16* V_lds = (bf16*)lds; bf16* K_lds = (bf16*)(lds + 2 * SHM_V);
  float* ws = (float*)(lds + 2 * SHM_V + 2 * SHM_K) + wid * 64; float* li_l = ws; float* al_l = ws + 32;
  float m_reg = -1e30f, l_reg = 0; f32x16 o[4] = {}; bf16x8 qr[8];
  const TQ* Qw = Qb + (long)(wid * QBLK + r32) * LDQ + hi * 8;
#pragma unroll
  for (int d0 = 0; d0 < 8; ++d0) qr[d0] = SQ::tobf(SQ::ld8(Qw + d0 * 16));
  const int sr = tid >> 4, sc = (tid & 15) * 8, vst0 = v_st(sr, sc), vst1 = v_st(32 + sr, sc);
  const int vb0 = (int)(uintptr_t)V_lds + v_rd_base(lane);
  struct { typename St::T vs0, vs1, ks0, ks1; } sr_[SDEPTH];
#define SLOAD(i, k0) do { sr_[i].vs0 = St::ld8(&Vh[(long)((k0) + sr) * LDK + sc]); sr_[i].vs1 = St::ld8(&Vh[(long)((k0) + 32 + sr) * LDK + sc]); \
    sr_[i].ks0 = St::ld8(&Kh[(long)((k0) + sr) * LDK + sc]); sr_[i].ks1 = St::ld8(&Kh[(long)((k0) + 32 + sr) * LDK + sc]); } while (0)
#define SWRITE(b, i) do { *(bf16x8*)((char*)V_lds + (b) * SHM_V + vst0) = St::tobf(sr_[i].vs0);          \
    *(bf16x8*)((char*)V_lds + (b) * SHM_V + vst1) = St::tobf(sr_[i].vs1); int kc = sc * 2;               \
    *(bf16x8*)((char*)K_lds + (b) * SHM_K + KSWZ(sr, kc)) = St::tobf(sr_[i].ks0);                       \
    *(bf16x8*)((char*)K_lds + (b) * SHM_K + KSWZ(32 + sr, kc)) = St::tobf(sr_[i].ks1); } while (0)
#define SWAIT() do { if constexpr (SDEPTH == 2) asm volatile("s_waitcnt vmcnt(4)" ::: "memory"); else asm volatile("s_waitcnt vmcnt(0)" ::: "memory"); } while (0)
#define RESC(a) do { if (__any((a) < 1.f)) { if (hi == 0) al_l[r32] = (a); asm volatile("s_waitcnt lgkmcnt(0)" ::: "memory"); \
    for (int d = 0; d < 4; ++d) for (int r = 0; r < 16; ++r) o[d][r] *= al_l[crow(r, hi)]; } } while (0)
  f32x16 pA0, pA1, pB0, pB1; float mnA, mnB, alA, alB; bf16x8 pa0, pa1, pa2, pa3; const int NT = seq / KVBLK;
  constexpr int SE = 0, SO = SDEPTH - 1;
  SLOAD(SE, 0); asm volatile("s_waitcnt vmcnt(0)" ::: "memory"); SWRITE(0, SE); __syncthreads();
  qkt(pA0, pA1, K_lds, qr, r32, hi); partialSM(pA0, pA1, m_reg, mnA, alA);
  SLOAD(SO, KVBLK); if constexpr (SDEPTH == 2) { if (2 < NT) SLOAD(SE, 2 * KVBLK); }
  SWAIT(); SWRITE(1, SO); __syncthreads();
  for (int j = 1; j + 1 < NT; j += 2) {
    SBAR(); qkt(pB0, pB1, (bf16*)((char*)K_lds + SHM_K), qr, r32, hi);
    finishSM(pA0, pA1, alA, l_reg, pa0, pa1, pa2, pa3); SBAR();
    SLOAD(SO, (j + SDEPTH) * KVBLK); SBAR();
    pv_d0(o, vb0, pa0, pa1, pa2, pa3); partialSM(pB0, pB1, m_reg, mnB, alB);
    __syncthreads(); SWAIT(); SWRITE(0, SE);
    RESC(alB); __syncthreads();
    SBAR(); qkt(pA0, pA1, K_lds, qr, r32, hi);
    finishSM(pB0, pB1, alB, l_reg, pa0, pa1, pa2, pa3); SBAR();
    if (SDEPTH == 1 || j + 3 < NT) SLOAD(SE, (j + 1 + SDEPTH) * KVBLK); SBAR();
    pv_d0(o, vb0 + (int)SHM_V, pa0, pa1, pa2, pa3); partialSM(pA0, pA1, m_reg, mnA, alA);
    __syncthreads(); SWAIT(); SWRITE(1, SO);
    RESC(alA); __syncthreads();
  }
  SBAR(); qkt(pB0, pB1, (bf16*)((char*)K_lds + SHM_K), qr, r32, hi);
  finishSM(pA0, pA1, alA, l_reg, pa0, pa1, pa2, pa3); SBAR();
  pv_d0(o, vb0, pa0, pa1, pa2, pa3); partialSM(pB0, pB1, m_reg, mnB, alB);
  __syncthreads(); RESC(alB);
  finishSM(pB0, pB1, alB, l_reg, pa0, pa1, pa2, pa3); SBAR();
  pv_d0(o, vb0 + (int)SHM_V, pa0, pa1, pa2, pa3);
  if (hi == 0) li_l[r32] = l_reg; asm volatile("s_waitcnt lgkmcnt(0)" ::: "memory");
  float rli[16];
#pragma unroll
  for (int r = 0; r < 16; ++r) rli[r] = __builtin_amdgcn_rcpf(li_l[crow(r, hi)]);
  { char* stg = lds + STG_OFF + wid * STG_WAVE;
#pragma unroll
    for (int r = 0; r < 16; ++r) { const int orow = crow(r, hi);
#pragma unroll
      for (int d0 = 0; d0 < 4; ++d0) *(bf16*)(stg + orow * 272 + (d0 * 32 + r32) * 2) = __float2bfloat16(o[d0][r] * rli[r]); }
    asm volatile("s_waitcnt lgkmcnt(0)" ::: "memory");
    int lane2 = lane; asm volatile("" : "+v"(lane2), "+s"(Gb), "+s"(Ob));
#pragma unroll
    for (int i = 0; i < 8; ++i) { const int id = i * 64 + lane2, row = id >> 4, ch = id & 15;
      const u32x4 ov = *(const u32x4*)(stg + row * 272 + ch * 16);
      const u32x4 gv = *(const u32x4*)(Gb + (long)(wid * QBLK + row) * LDQ + ch * 8);
      u32x4 w;
#define SG(o_, g_) ((o_) * (g_) * __builtin_amdgcn_rcpf(1.f + __expf(-(g_))))
#define LO(x) __uint_as_float((x) << 16)
#define HI(x) __uint_as_float((x) & 0xffff0000u)
      w.x = cvtpk(SG(LO(ov.x), LO(gv.x)), SG(HI(ov.x), HI(gv.x))); w.y = cvtpk(SG(LO(ov.y), LO(gv.y)), SG(HI(ov.y), HI(gv.y)));
      w.z = cvtpk(SG(LO(ov.z), LO(gv.z)), SG(HI(ov.z), HI(gv.z))); w.w = cvtpk(SG(LO(ov.w), LO(gv.w)), SG(HI(ov.w), HI(gv.w)));
#undef SG
#undef LO
#undef HI
      *(u32x4*)(Ob + (long)(wid * QBLK + row) * LDO + ch * 8) = w; } }
  __syncthreads();
#undef SLOAD
#undef SWRITE
#undef SWAIT
#undef RESC
}
}
#undef SBAR
#undef KSWZ
#define LAS __attribute__((address_space(3)))
typedef unsigned short bf16_t;
typedef float f32x4 __attribute__((ext_vector_type(4)));
typedef unsigned u32x4 __attribute__((ext_vector_type(4)));
typedef unsigned u32x2 __attribute__((ext_vector_type(2)));
typedef short bf16x8 __attribute__((ext_vector_type(8)));

constexpr int DM = 2048, MC = 4096, ML = 8192, MT = 12288;
constexpr int INC = 5120, MGC = 6144, NCAT = INC + MGC, NCAT1 = NCAT - 2048;
constexpr int C_Q = 0, C_K = 1024, C_V = 1280, C_GA = 1536, C_U = 2560, C_VB = 3072, C_GB = 3584, C_Z = 4096, C_GC = 4608;
constexpr int KVLAT = 2304;
constexpr float EPS = 1e-6f;
constexpr size_t OFF_SK = (size_t)MT * DM, OFF_SV = OFF_SK + 16 * 2 * 256 * 256;
constexpr size_t MiB = 1u << 20;
constexpr size_t WS_ROPE = 64 * 1024, WS_MOD = 128 * 1024, WS_WPOOL = 512 * 1024;
constexpr size_t WS_WCAT = 1 * MiB, WS_WBRA = 45 * MiB, WS_WBRB = 49 * MiB, WS_WBRC = 51 * MiB, WS_WOUT = 53 * MiB;
constexpr size_t WS_MIX = 387 * MiB, WS_MERGED = 109 * MiB;
constexpr size_t WS_H = 61 * MiB, WS_PROJ = 109 * MiB, WS_GATES = 229 * MiB, WS_KB = 373 * MiB, WS_VB = 380 * MiB, WS_END = 435 * MiB;
constexpr int LDS_BYTES = 147456, LDS_CTL = 147200;
constexpr int NPH = 10;
constexpr int CW_TMO = 3500, CW_CNT = 4096;
constexpr size_t CTL_ZERO_BYTES = 65536;

__device__ __forceinline__ float bflo(unsigned u) { return __uint_as_float(u << 16); }
__device__ __forceinline__ float bfhi(unsigned u) { return __uint_as_float(u & 0xffff0000u); }
__device__ __forceinline__ unsigned f2bf(float f) { unsigned u = __float_as_uint(f); return (u + 0x7fffu + ((u >> 16) & 1u)) >> 16; }
__device__ __forceinline__ unsigned pk2(float lo, float hi) { return pg8::cvt_pk_bf16(lo, hi); }
__device__ __forceinline__ float silu_f(float g) { return g * __builtin_amdgcn_rcpf(1.f + __expf(-g)); }
__device__ __forceinline__ float wave_sum(float v) {
#pragma unroll
    for (int o = 1; o < 64; o <<= 1) v += __shfl_xor(v, o);
    return v;
}

struct Args { const float* in[24]; float* out; unsigned char* ws; int ph_lo, ph_hi; };

__host__ __device__ __forceinline__ int sig_inv(int d) { const int hi = (d >> 5) & 1, q = (d & 31) + ((d >> 6) << 5); return 8 * (q >> 2) + (q & 3) + 4 * hi; }
__device__ __forceinline__ void tr_item(const float* W, int K, int N, bf16_t* WT, int row_off, LAS float* scr, int item, int lane, int ldo = 0, int koff = 0, bool perm = false) {
    if (ldo == 0) ldo = K;
    const int nblk = N / 32, kb = item / nblk, nb = item % nblk, k0 = 64 * kb, n0 = 32 * nb;
#pragma unroll 8
    for (int i = 0; i < 32; ++i) { const int kk = 2 * i + (lane >> 5); scr[kk * 33 + (lane & 31)] = __builtin_nontemporal_load(W + (size_t)(k0 + kk) * N + n0 + (lane & 31)); }
    asm volatile("s_waitcnt lgkmcnt(0)" ::: "memory");
    const int c = lane & 7;
#pragma unroll
    for (int j = 0; j < 4; ++j) { const int n = (lane >> 3) + 8 * j; const LAS float* s = scr + (8 * c) * 33 + n;
        u32x4 o; o.x = pk2(s[0 * 33], s[1 * 33]); o.y = pk2(s[2 * 33], s[3 * 33]); o.z = pk2(s[4 * 33], s[5 * 33]); o.w = pk2(s[6 * 33], s[7 * 33]);
        int nr = row_off + n0 + n; if (perm && nr < 1280) nr = (nr & ~127) + sig_inv(nr & 127);
        *(u32x4*)(WT + (size_t)nr * ldo + koff + k0 + 8 * c) = o; }
    asm volatile("s_waitcnt lgkmcnt(0)" ::: "memory");
}
__device__ __forceinline__ void convert_weights(const Args& a, int l, LAS float* scr, int gw, int NGW, int lane, bool pool) {
    unsigned char* ws = a.ws;
    constexpr int I_IN = 32 * 160, I_MG = 32 * 192, I_A = 16 * 64, I_B = 8 * 64, I_O = 32 * 64;
    constexpr int NIT = I_IN + I_MG + I_A + 2 * I_B + I_O;
    const int nit = NIT + (pool ? 64 : 0);
    for (int it = gw; it < nit; it += NGW) {
        int r = it;
        if (r < I_IN) { tr_item(a.in[9] + (size_t)l * 2048 * 5120, 2048, 5120, (bf16_t*)(ws + WS_WCAT), 0, scr, r, lane, 0, 0, true); continue; } r -= I_IN;
        if (r < I_MG) { tr_item(a.in[20] + (size_t)l * 2048 * 6144, 2048, 6144, (bf16_t*)(ws + WS_WCAT), 5120, scr, r, lane); continue; } r -= I_MG;
        if (r < I_A) { tr_item(a.in[17] + (size_t)l * 1024 * 2048, 1024, 2048, (bf16_t*)(ws + WS_WBRA), 0, scr, r, lane, 2048, 0); continue; } r -= I_A;
        if (r < I_B) { tr_item(a.in[18] + (size_t)l * 512 * 2048, 512, 2048, (bf16_t*)(ws + WS_WBRA), 0, scr, r, lane, 2048, 1024); continue; } r -= I_B;
        if (r < I_B) { tr_item(a.in[19] + (size_t)l * 512 * 2048, 512, 2048, (bf16_t*)(ws + WS_WBRA), 0, scr, r, lane, 2048, 1536); continue; } r -= I_B;
        if (r < I_O) { tr_item(a.in[22] + (size_t)l * 2048 * 2048, 2048, 2048, (bf16_t*)(ws + WS_WOUT), 0, scr, r, lane); continue; } r -= I_O;
        { const int mat = r >> 3; tr_item(a.in[15] + (size_t)mat * 16384, 128, 128, (bf16_t*)(ws + WS_WPOOL) + (size_t)mat * 16384, 0, scr, r & 7, lane); }
    }
}

__device__ __forceinline__ void phase_prologue(const Args& a, unsigned char* lds, int tid, int lane, int wave, int bx, int G, int gw, int NGW) {
    float* mod = (float*)(a.ws + WS_MOD);
    for (int u = bx; u < 192; u += G) {
        const int l = u / 96, cb = u % 96;
        LAS float* sv = (LAS float*)lds; LAS float* red = sv + 5 * 2048;
        for (int i = tid; i < 5 * 2048; i += 512) { const int j = i >> 11, k = i & 2047; const float c = (j == 0) ? a.in[5][k] : a.in[4][(j - 1) * 2048 + k]; sv[i] = c / (1.f + __expf(-c)); }
        __syncthreads();
        const float* W = a.in[7] + (size_t)l * 2048 * 6144 + cb * 64 + lane;
        float a0 = 0.f, a1 = 0.f, a2 = 0.f, a3 = 0.f, a4 = 0.f;
        const int k0 = wave * 256;
#pragma unroll 32
        for (int k = k0; k < k0 + 256; ++k) { const float w = __builtin_nontemporal_load(W + (size_t)k * 6144); a0 += sv[k] * w; a1 += sv[2048 + k] * w; a2 += sv[4096 + k] * w; a3 += sv[6144 + k] * w; a4 += sv[8192 + k] * w; }
        red[(wave * 5 + 0) * 64 + lane] = a0; red[(wave * 5 + 1) * 64 + lane] = a1; red[(wave * 5 + 2) * 64 + lane] = a2; red[(wave * 5 + 3) * 64 + lane] = a3; red[(wave * 5 + 4) * 64 + lane] = a4;
        __syncthreads();
        if (tid < 320) { const int j = tid >> 6; float s = 0.f;
#pragma unroll
            for (int w = 0; w < 8; ++w) s += red[(w * 5 + j) * 64 + lane];
            const int col = cb * 64 + lane; mod[(size_t)(l * 5 + j) * 6144 + col] = s + a.in[8][l * 6144 + col]; }
        __syncthreads();
    }
    if (bx == G - 1 && wave == 7 && lane < 32) {
        double inv = 1.0; for (int i = 0; i < lane; ++i) inv *= 0.7498942093324559;
        const double x2 = inv * inv; double c = 1.0, s = inv, tc = 1.0, ts = inv;
        for (int n = 1; n <= 12; ++n) { tc *= -x2 / (double)((2 * n - 1) * (2 * n)); ts *= -x2 / (double)((2 * n) * (2 * n + 1)); c += tc; s += ts; }
        float* tab = (float*)(a.ws + WS_ROPE); double cr = 1.0, sr = 0.0;
        for (int p = 0; p < 64; ++p) { tab[(p * 32 + lane) * 2] = (float)cr; tab[(p * 32 + lane) * 2 + 1] = (float)sr; const double ncr = cr * c - sr * s; sr = sr * c + cr * s; cr = ncr; }
    }
    convert_weights(a, 0, (LAS float*)((LAS unsigned char*)lds + wave * 16384), gw, NGW, lane, true);
}

__device__ __forceinline__ void phase_norm(const Args& a, int l, int gw, int NGW, int lane) {
    const float* xc = l == 0 ? a.in[0] : a.out; const float* xl = l == 0 ? a.in[1] : a.out + (size_t)MC * DM;
    const float* nw = a.in[6] + l * DM; const float* mod = (const float*)(a.ws + WS_MOD) + (size_t)l * 5 * 6144;
    bf16_t* H = (bf16_t*)(a.ws + WS_H);
    for (int m = gw; m < MT; m += NGW) {
        const float* xr = (m < MC) ? xc + (size_t)m * DM : xl + (size_t)(m - MC) * DM;
        const float* md = mod + ((m < MC) ? 0 : 1 + ((m - MC) >> 11)) * 6144;
        f32x4 v[8]; float s = 0.f;
#pragma unroll
        for (int j = 0; j < 8; ++j) { v[j] = ((const f32x4*)xr)[lane + 64 * j]; s += (v[j].x * v[j].x + v[j].y * v[j].y) + (v[j].z * v[j].z + v[j].w * v[j].w); }
        const float rstd = 1.f / sqrtf(wave_sum(s) * (1.f / DM) + EPS);
#pragma unroll
        for (int j = 0; j < 8; ++j) { const int col = 4 * (lane + 64 * j);
            const f32x4 w = *(const f32x4*)(nw + col), sh = *(const f32x4*)(md + col), sc = *(const f32x4*)(md + 2048 + col);
            const f32x4 y = v[j] * rstd * w * (sc + 1.f) + sh; u32x2 o; o.x = pk2(y.x, y.y); o.y = pk2(y.z, y.w);
            *(u32x2*)(H + (size_t)m * DM + col) = o; }
    }
}
__device__ __forceinline__ void cache_rows(const Args& a, int l, int gw, int NGW, int lane) {
    bf16_t* KB = (bf16_t*)(a.ws + WS_KB); bf16_t* VB = (bf16_t*)(a.ws + WS_VB);
    for (int i = gw; i < 1024; i += NGW) { const int b = i >> 8, jj = i & 255; const size_t src = ((size_t)(b * 2 + l) * 256 + jj) * 256, dst = ((size_t)MC + (size_t)b * KVLAT + 2048 + jj) * 256 + 4 * lane;
        const int p4 = (4 * lane) & 127, kh = (4 * lane) >> 7, q = 4 * (p4 >> 3) + 0, bs = (q < 32 ? q : q + 32) + ((p4 & 4) ? 32 : 0);
        const f32x4 k = *(const f32x4*)(a.in[2] + src + kh * 128 + bs), v = *(const f32x4*)(a.in[3] + src + 4 * lane);
        u32x2 ko, vo; ko.x = pk2(k.x, k.y); ko.y = pk2(k.z, k.w); vo.x = pk2(v.x, v.y); vo.y = pk2(v.z, v.w);
        *(u32x2*)(KB + dst) = ko; *(u32x2*)(VB + dst) = vo; }
}
__device__ __forceinline__ void phase_final(const Args& a, int gw, int NGW, int lane) {
    const float* nw = a.in[23];
    for (int m = gw; m < MT; m += NGW) {
        float* xr = a.out + (size_t)m * DM; f32x4 v[8]; float s = 0.f;
#pragma unroll
        for (int j = 0; j < 8; ++j) { v[j] = ((const f32x4*)xr)[lane + 64 * j]; s += (v[j].x * v[j].x + v[j].y * v[j].y) + (v[j].z * v[j].z + v[j].w * v[j].w); }
        const float rstd = 1.f / sqrtf(wave_sum(s) * (1.f / DM) + EPS);
#pragma unroll
        for (int j = 0; j < 8; ++j) { const int col = 4 * (lane + 64 * j); __builtin_nontemporal_store(v[j] * rstd * *(const f32x4*)(nw + col), (f32x4*)xr + lane + 64 * j); }
    }
}

__device__ __forceinline__ void unpack8(const u32x4 v, float* x) { x[0] = bflo(v.x); x[1] = bfhi(v.x); x[2] = bflo(v.y); x[3] = bfhi(v.y); x[4] = bflo(v.z); x[5] = bfhi(v.z); x[6] = bflo(v.w); x[7] = bfhi(v.w); }
__device__ __forceinline__ u32x4 pack8(const float* x) { u32x4 o; o.x = pk2(x[0], x[1]); o.y = pk2(x[2], x[3]); o.z = pk2(x[4], x[5]); o.w = pk2(x[6], x[7]); return o; }
__device__ __forceinline__ void mm128(const LAS unsigned char* X, const LAS unsigned char* Y, int wave, int fr, int fq, f32x4 (&acc)[8]) {
    bf16x8 yb[4];
#pragma unroll
    for (int k = 0; k < 4; ++k) yb[k] = *(const LAS bf16x8*)(Y + (16 * wave + fr) * 272 + (k * 32 + fq * 8) * 2);
#pragma unroll
    for (int cb = 0; cb < 8; ++cb) { acc[cb] = (f32x4){0.f, 0.f, 0.f, 0.f};
#pragma unroll
        for (int k = 0; k < 4; ++k) { const bf16x8 xa = *(const LAS bf16x8*)(X + (16 * cb + fr) * 272 + (k * 32 + fq * 8) * 2);
            acc[cb] = __builtin_amdgcn_mfma_f32_16x16x32_bf16(xa, yb[k], acc[cb], 0, 0, 0); } }
}
constexpr int P3_X = 0, P3_Y = 34816, P3_Z = 69632;
__device__ __forceinline__ void sgu_unit(const Args& a, int l, int n, int g0, int g1, LAS unsigned char* lds, int tid, int lane, int wave) {
    bf16_t* PROJ = (bf16_t*)(a.ws + WS_PROJ); bf16_t* MIX = (bf16_t*)(a.ws + WS_MIX);
    asm volatile("" : "+v"(tid), "+v"(lane));
    const int q = tid >> 2, part = tid & 3, fr = lane & 15, fq = lane >> 4;
    const size_t rowoff = (size_t)(128 * n + q) * INC;
    u32x4 rv[16], xr[2][4]; f32x4 yr[2][8];
    { const bf16_t* p = PROJ + rowoff + C_VB + part * 128;
#pragma unroll
      for (int i = 0; i < 16; ++i) rv[i] = *(const u32x4*)(p + 8 * i); }
#pragma unroll
    for (int gi = 0; gi < 2; ++gi) { const int g = g0 + gi; const bf16_t* p = PROJ + rowoff + C_VB + g * 128 + part * 32; const float* W = a.in[13] + ((size_t)(l * 4 + g) * 128 + q) * 128 + part * 32;
#pragma unroll
        for (int i = 0; i < 4; ++i) xr[gi][i] = *(const u32x4*)(p + 8 * i);
#pragma unroll
        for (int i = 0; i < 8; ++i) yr[gi][i] = *(const f32x4*)(W + 4 * i); }
    float ss = 0.f;
#pragma unroll
    for (int i = 0; i < 16; ++i) { float f[8]; unpack8(rv[i], f);
#pragma unroll
        for (int e = 0; e < 8; ++e) ss += f[e] * f[e]; }
    ss += __shfl_xor(ss, 1); ss += __shfl_xor(ss, 2);
    const float rs = 1.f / sqrtf(ss * (1.f / 512.f) + EPS);
#pragma unroll
    for (int gi = 0; gi < 2; ++gi) { const int g = g0 + gi; LAS unsigned char* X = lds + gi * 69632 + P3_X; LAS unsigned char* Y = lds + gi * 69632 + P3_Y;
        const float* nw = a.in[12] + l * 512 + g * 128 + part * 32;
#pragma unroll
        for (int i = 0; i < 4; ++i) { float f[8]; unpack8(xr[gi][i], f); const f32x4 n0 = *(const f32x4*)(nw + 8 * i), n1 = *(const f32x4*)(nw + 8 * i + 4);
#pragma unroll
            for (int e = 0; e < 8; ++e) *(LAS bf16_t*)(X + (part * 32 + 8 * i + e) * 272 + q * 2) = (bf16_t)f2bf(f[e] * rs * (e < 4 ? n0[e] : n1[e - 4])); }
#pragma unroll
        for (int i = 0; i < 4; ++i) { const f32x4 w0 = yr[gi][2 * i], w1 = yr[gi][2 * i + 1];
            u32x4 o; o.x = pk2(w0.x, w0.y); o.y = pk2(w0.z, w0.w); o.z = pk2(w1.x, w1.y); o.w = pk2(w1.z, w1.w);
            *(LAS u32x4*)(Y + q * 272 + (part * 32 + 8 * i) * 2) = o; } }
    __syncthreads();
    const int p = 16 * wave + fr; const size_t ro = (size_t)(128 * n + p) * INC;
#pragma unroll
    for (int gi = 0; gi < 2; ++gi) { const int g = g0 + gi;
        u32x2 uu[8], gg[8];
#pragma unroll
        for (int cb = 0; cb < 8; ++cb) { const int c = g * 128 + 16 * cb + 4 * fq; uu[cb] = *(const u32x2*)(PROJ + ro + C_U + c); gg[cb] = *(const u32x2*)(PROJ + ro + C_GB + c); }
        const float bs = a.in[14][(l * 4 + g) * 128 + p];
        f32x4 acc[8]; mm128(lds + gi * 69632 + P3_X, lds + gi * 69632 + P3_Y, wave, fr, fq, acc);
#pragma unroll
        for (int cb = 0; cb < 8; ++cb) { const int c = g * 128 + 16 * cb + 4 * fq;
            const float v0 = bflo(uu[cb].x) * (acc[cb].x + bs) * silu_f(bflo(gg[cb].x)), v1 = bfhi(uu[cb].x) * (acc[cb].y + bs) * silu_f(bfhi(gg[cb].x));
            const float v2 = bflo(uu[cb].y) * (acc[cb].z + bs) * silu_f(bflo(gg[cb].y)), v3 = bfhi(uu[cb].y) * (acc[cb].w + bs) * silu_f(bfhi(gg[cb].y));
            u32x2 o; o.x = pk2(v0, v1); o.y = pk2(v2, v3); *(u32x2*)(MIX + (size_t)(128 * n + p) * DM + 1024 + c) = o; } }
    __syncthreads();
}
__device__ __forceinline__ void pool_unit(const Args& a, int l, int n, int g0, int g1, LAS unsigned char* lds, int tid, int lane, int wave) {
    bf16_t* PROJ = (bf16_t*)(a.ws + WS_PROJ); bf16_t* MIX = (bf16_t*)(a.ws + WS_MIX);
    LAS unsigned char* X = lds + P3_X; LAS unsigned char* Y = lds + P3_Y; LAS float* Z = (LAS float*)(lds + P3_Z);
    const int row0 = 128 * n; const bool lat = row0 >= MC; const int seqlen = lat ? 2048 : 256; const int t0 = lat ? ((row0 - MC) & 2047) : (row0 & 255);
    asm volatile("" : "+v"(tid), "+v"(lane));
    const int fr = lane & 15, fq = lane >> 4;
    u32x4 zr[5], xw[4];
#define POOL_PREFETCH(gi_) do { _Pragma("unroll") for (int i = 0; i < 5; ++i) { const int ch = tid + 512 * i; const int r = ch >> 4, c8 = (ch & 15) * 8, pos = t0 - 8 + r; \
            zr[i] = (u32x4){0u, 0u, 0u, 0u}; if (ch < 144 * 16 && pos >= 0 && pos < seqlen) zr[i] = *(const u32x4*)(PROJ + (size_t)(row0 - 8 + r) * INC + C_Z + (gi_) * 128 + c8); } \
        { const bf16_t* WP = (const bf16_t*)(a.ws + WS_WPOOL) + (size_t)(l * 4 + (gi_)) * 16384 + (tid >> 2) * 128 + (tid & 3) * 32; \
          _Pragma("unroll") for (int i = 0; i < 4; ++i) xw[i] = *(const u32x4*)(WP + 8 * i); } } while (0)
    POOL_PREFETCH(g0);
    for (int gi = g0; gi < g1; ++gi) {
        const int w = 2 << gi, hw = w >> 1;
#pragma unroll
        for (int i = 0; i < 5; ++i) { const int ch = tid + 512 * i; if (ch < 144 * 16) { const int r = ch >> 4, c8 = (ch & 15) * 8; float f[8]; unpack8(zr[i], f);
            *(LAS f32x4*)(Z + r * 128 + c8) = (f32x4){f[0], f[1], f[2], f[3]}; *(LAS f32x4*)(Z + r * 128 + c8 + 4) = (f32x4){f[4], f[5], f[6], f[7]}; } }
#pragma unroll
        for (int i = 0; i < 4; ++i) *(LAS u32x4*)(X + (tid >> 2) * 272 + ((tid & 3) * 32 + 8 * i) * 2) = xw[i];
        if (gi + 1 < g1) POOL_PREFETCH(gi + 1);
        const int tl = 16 * wave + fr; const size_t ro = (size_t)(row0 + tl) * INC;
        u32x2 gg[8]; f32x4 ps[8];
#pragma unroll
        for (int cb = 0; cb < 8; ++cb) { const int dch = gi * 128 + 16 * cb + 4 * fq; ps[cb] = *(const f32x4*)(a.in[16] + l * 512 + dch); gg[cb] = *(const u32x2*)(PROJ + ro + C_GC + dch); }
        __syncthreads();
        { const int c = tid & 127, t = 32 * (tid >> 7); float s = 0.f;
          for (int k = 0; k < w; ++k) s += Z[(t + 8 - hw + k) * 128 + c];
          for (int tt = 0; tt < 32; ++tt) { const int tl2 = t + tt, pos = t0 + tl2; const int lo = max(pos - hw, 0), hi = min(pos + w - hw, seqlen);
              const float dv = s / (float)(hi - lo) - Z[(tl2 + 8) * 128 + c];
              *(LAS bf16_t*)(Y + tl2 * 272 + c * 2) = (bf16_t)f2bf(dv);
              s += Z[(tl2 + 8 - hw + w) * 128 + c] - Z[(tl2 + 8 - hw) * 128 + c]; } }
        __syncthreads();
        f32x4 acc[8]; mm128(X, Y, wave, fr, fq, acc);
#pragma unroll
        for (int cb = 0; cb < 8; ++cb) { const int dch = gi * 128 + 16 * cb + 4 * fq;
            u32x2 o; o.x = pk2(acc[cb].x * ps[cb].x * silu_f(bflo(gg[cb].x)), acc[cb].y * ps[cb].y * silu_f(bfhi(gg[cb].x))); o.y = pk2(acc[cb].z * ps[cb].z * silu_f(bflo(gg[cb].y)), acc[cb].w * ps[cb].w * silu_f(bfhi(gg[cb].y)));
            *(u32x2*)(MIX + (size_t)(row0 + tl) * DM + 1536 + dch) = o; }
        __syncthreads();
    }
#undef POOL_PREFETCH
}
#define RLX_AGENT __ATOMIC_RELAXED, __HIP_MEMORY_SCOPE_AGENT
#define XB_TMO      128
#define XB_XCNT(j)  (256  + 64 * (j))
#define XB_XSUB(j)  (1280 + 64 * (j))
#define XB_XGEN(j)  (2304 + 64 * (j))
#define XB_TOP      3328
#define XB_TOPGEN   3392
#define XCD_BAR_WORDS 3456
#define XB_SPIN_CAP (1u << 18)

__device__ __forceinline__ unsigned xb_ld(unsigned* p)              { return __hip_atomic_load(p, __ATOMIC_RELAXED, __HIP_MEMORY_SCOPE_AGENT); }
__device__ __forceinline__ unsigned xb_add(unsigned* p, unsigned v) { return __hip_atomic_fetch_add(p, v, __ATOMIC_RELAXED, __HIP_MEMORY_SCOPE_AGENT); }
__device__ __forceinline__ unsigned xb_xcc_id() { return (unsigned)__builtin_amdgcn_s_getreg((3 << 11) | 20) & 0xFu; }
#define XB_SPIN(cond, bar) do { unsigned _sp = 0; while (cond) { __builtin_amdgcn_s_sleep(1); \
    if ((++_sp & 255u) == 0u) { if (xb_ld(&(bar)[XB_TMO])) break; if (_sp > XB_SPIN_CAP) { atomicAdd(&(bar)[XB_TMO], 1u); break; } } } } while (0)

struct XcdBarrier {
    unsigned* bar; unsigned x;
    volatile LAS unsigned* st;
};

__device__ __forceinline__ XcdBarrier xcd_barrier_post(unsigned* bar, volatile LAS unsigned* st) {
    XcdBarrier b; b.bar = bar; b.x = xb_xcc_id(); b.st = st;
    if (threadIdx.x == 0) (void)xb_add(&bar[XB_XCNT(b.x)], 1u);
    return b;
}
__device__ __forceinline__ void xcd_barrier_complete(unsigned* bar, unsigned x, unsigned& nloc, unsigned& nx) {
    const unsigned G = gridDim.x * gridDim.y * gridDim.z;
    unsigned sum, cnt, mine, sp = 0u;
    for (;;) {
        sum = 0u; cnt = 0u; mine = 0u;
#pragma unroll
        for (unsigned j = 0; j < 16; ++j) { const unsigned c = xb_ld(&bar[XB_XCNT(j)]); sum += c; cnt += (c > 0u) ? 1u : 0u; mine = (j == x) ? c : mine; }
        if (sum == G) break;
        __builtin_amdgcn_s_sleep(1);
        if ((++sp & 255u) == 0u) { if (xb_ld(&bar[XB_TMO])) break; if (sp > XB_SPIN_CAP) { atomicAdd(&bar[XB_TMO], 1u); break; } }
    }
    nloc = mine > 0u ? mine : 1u; nx = cnt > 0u ? cnt : 1u;
}

__device__ __forceinline__ void xcd_barrier(const XcdBarrier& b) {
    asm volatile("s_waitcnt vmcnt(0)" ::: "memory");
    __syncthreads();
    if (threadIdx.x == 0) {
        unsigned* bar = b.bar;
        __builtin_amdgcn_s_waitcnt(0);
        unsigned nloc = b.st[0], nx = b.st[1];
        if (nloc == 0u) { xcd_barrier_complete(bar, b.x, nloc, nx); b.st[0] = nloc; b.st[1] = nx; }
        const unsigned old = xb_add(&bar[XB_XSUB(b.x)], 1u);
        const unsigned gen = old / nloc;
        if (old + 1u == (gen + 1u) * nloc) {
            __builtin_amdgcn_fence(__ATOMIC_RELEASE, "agent");
            asm volatile("s_waitcnt vmcnt(0)" ::: "memory");
            const unsigned og = xb_add(&bar[XB_TOP], 1u);
            const unsigned tg = og / nx;
            if (og + 1u == (tg + 1u) * nx) xb_add(&bar[XB_TOPGEN], 1u);
            else XB_SPIN(xb_ld(&bar[XB_TOPGEN]) == tg, bar);
            __builtin_amdgcn_fence(__ATOMIC_ACQUIRE, "agent");
            xb_add(&bar[XB_XGEN(b.x)], 1u);
            asm volatile("s_waitcnt vmcnt(0)" ::: "memory");
        } else {
            XB_SPIN(xb_ld(&bar[XB_XGEN(b.x)]) == gen, bar);
            __builtin_amdgcn_fence(__ATOMIC_ACQUIRE, "agent");
            asm volatile("s_waitcnt vmcnt(0)" ::: "memory");
        }
    }
    __syncthreads();
}
#if defined(__HIP_DEVICE_COMPILE__)
#define LOAD_ARGS asm volatile("" : "+s"(ap)); const Args a = *ap; unsigned char* ws = a.ws; (void)ws
#else
#define LOAD_ARGS const Args a = a_unused; unsigned char* ws = a.ws; (void)ws
#endif
#ifndef PH_EN
#define PH_EN 0xff
#endif
#ifndef PROBE_PH
#define PROBE_PH 0
#endif
#ifndef PROBE_N
#define PROBE_N 0
#endif
#ifndef PROBE_MASK
#define PROBE_MASK 15
#endif
__global__ void __launch_bounds__(512, 2) mk_fwd(Args a_unused) {
    extern __shared__ __attribute__((aligned(16))) unsigned char lds[];
    if (threadIdx.x < 16) ((LAS unsigned*)((LAS unsigned char*)lds + LDS_CTL))[threadIdx.x] = 0u;
    __syncthreads();
    XcdBarrier bar = xcd_barrier_post((unsigned*)a_unused.ws + 0, (volatile LAS unsigned*)((LAS unsigned char*)lds + LDS_CTL));
    LAS unsigned char* L = (LAS unsigned char*)lds;
    typedef const __attribute__((address_space(4))) Args CArgs;
    CArgs* ap = (CArgs*)__builtin_amdgcn_kernarg_segment_ptr();
    (void)bar;
    for (int ph = 0; ; ++ph) {
        asm volatile("" : "+s"(ap));
        if (ph >= ap->ph_hi) break;
        if (ph > 0) { XcdBarrier b2; b2.bar = (unsigned*)ap->ws; b2.x = xb_xcc_id(); b2.st = (volatile LAS unsigned*)((LAS unsigned char*)lds + LDS_CTL); xcd_barrier(b2); }
        asm volatile("" : "+s"(ap));
        int tid = threadIdx.x, G = gridDim.x, bx = blockIdx.x;
        asm volatile("" : "+v"(tid), "+s"(G), "+s"(bx));
        const int lane = tid & 63, wave = __builtin_amdgcn_readfirstlane(tid >> 6);
        const int vcu = (G % 8 == 0) ? (bx % 8) * (G / 8) + bx / 8 : bx;
        const int gw = vcu * 8 + wave, NGW = G * 8;
        const bool probe = (PROBE_N > 0) && ph >= NPH; const int eph = probe ? PROBE_PH : ph;
        if (eph == 0) { LOAD_ARGS; if (PH_EN & 1) phase_prologue(a, lds, tid, lane, wave, bx, G, gw, NGW); continue; }
        if (eph == NPH - 1) { LOAD_ARGS; if (PH_EN & 128) phase_final(a, gw, NGW, lane); continue; }
        const int l = (eph - 1) / 4, s = (eph - 1) % 4;
        if (s == 0 && (PH_EN & 2)) { LOAD_ARGS;
            phase_norm(a, l, gw, NGW, lane);
            cache_rows(a, l, gw, NGW, lane);
            if (l == 1) convert_weights(a, 1, (LAS float*)(L + wave * 16384), gw, NGW, lane, false);
        } else if (s == 1 && (PH_EN & 4)) { LOAD_ARGS;
            pg8::Gemm g{(const bf16_t*)(ws + WS_H), (const bf16_t*)(ws + WS_WCAT), MT, NCAT1, DM, DM}; pg8::Gemm1Order S; S.init(MT, NCAT1, G, bx);
            pg8::EpiProj E{(bf16_t*)(ws + WS_PROJ), (bf16_t*)(ws + WS_GATES), a.in[21] + l * MGC, (probe && (PROBE_MASK & 16)) ? 1 : 0, 0, ws, a.out, a.in[10] + l * 128, a.in[11] + l * 128, l, (PG8_LAS float*)(L + 131072)};
            pg8::gemm_phase<pg8::EpiProj, pg8::Gemm1Order, true, true>(L, g, S, E);
        } else if (s == 2 && (PH_EN & 16)) { LOAD_ARGS;
            const att::bf16* PROJ = (const att::bf16*)(ws + WS_PROJ); const att::bf16* KB = (const att::bf16*)(ws + WS_KB); const att::bf16* VB = (const att::bf16*)(ws + WS_VB);
            att::bf16* MIX = (att::bf16*)(ws + WS_MIX);
            if (!probe || (PROBE_MASK & 32)) {
                pg8::Gemm g{(const bf16_t*)(ws + WS_H), (const bf16_t*)(ws + WS_WCAT) + (size_t)NCAT1 * DM, MT, 2048, DM, DM}; pg8::DeferOrder S{G, bx};
                pg8::EpiProj E{(bf16_t*)(ws + WS_PROJ), (bf16_t*)(ws + WS_GATES), a.in[21] + l * MGC, 0, 36, ws, a.out, a.in[10] + l * 128, a.in[11] + l * 128, l, (PG8_LAS float*)(L + 131072)};
                pg8::gemm_phase<pg8::EpiProj, pg8::DeferOrder, true, true>(L, g, S, E);
            }
            for (int k = 0; ; ++k) {
                int u;
                if (G == 256) { const int cc = bx - 64; if (k > (bx < 64 ? 0 : (cc < 128 ? 3 : 2))) break; u = (k == 0) ? vcu : 256 + (k - 1) * 192 + cc; }
                else { u = vcu + k * G; if (u >= 768) break; }
                const int sm = u - 256;
                if (probe) { const int kind = u < 256 ? 1 : (sm < 192 ? 2 : (sm < 384 ? 4 : 8)); if (!(PROBE_MASK & kind)) continue; }
                if (u >= 256 && sm < 384) {
#if defined(__HIP_DEVICE_COMPILE__)
                    asm volatile("" : "+s"(ap)); const Args a2 = *ap;
#else
                    const Args a2 = a_unused;
#endif
                    if (sm < 192) sgu_unit(a2, l, sm >> 1, (sm & 1) * 2, (sm & 1) * 2 + 2, L, tid, lane, wave);
                    else { const int pu = sm - 192; pool_unit(a2, l, pu >> 1, (pu & 1) * 2, (pu & 1) * 2 + 2, L, tid, lane, wave); }
                    continue; }
                int qrow0, kvrow0, h, seq;
                if (u < 256) { const int b = u >> 6, qb = u & 7; h = (u >> 3) & 7; qrow0 = MC + b * 2048 + qb * 256; kvrow0 = MC + b * KVLAT; seq = KVLAT; }
                else { const int uu = sm - 384, b = uu >> 3; h = uu & 7; qrow0 = b * 256; kvrow0 = b * 256; seq = 256; }
                const att::bf16* Q = PROJ + (size_t)qrow0 * INC + h * 128; const size_t ko = (size_t)kvrow0 * 256 + (h >> 2) * 128;
                att::attn_dense_body<att::bf16>(Q, KB + ko, VB + ko, Q + C_GA, MIX + (size_t)qrow0 * DM + h * 128, seq, (char*)lds);
            }
        } else if (s == 3 && (PH_EN & 32)) { LOAD_ARGS;
            pg8::Gemm2 g{(const bf16_t*)(ws + WS_MIX), (const bf16_t*)(ws + WS_WBRA), (const bf16_t*)(ws + WS_MERGED), (const bf16_t*)(ws + WS_WOUT), MT, DM, DM, DM};
            pg8::FusedOrder S{G, bx, (unsigned*)ws + CW_CNT + l * 4096};
            pg8::EpiFused E{ws, l == 0 ? a.in[0] : a.out, l == 0 ? a.in[1] : a.out + (size_t)MC * DM, a.out, l, WS_MERGED, WS_GATES, WS_MOD, probe ? 1 : 0};
            pg8::gemm_fused<pg8::EpiFused, pg8::FusedOrder, true, true>(L, g, S, E);
        }
    }
}

extern "C" void kernel_launch(void* const* d_in, const int* in_sizes, int n_in, void* d_out, int out_size, void* d_ws, size_t ws_size, hipStream_t stream) {
    static int grid = 0;
    if (grid == 0) {
        if (n_in != 24 || ws_size < WS_END) { fprintf(stderr, "kernel_launch: expected 24 inputs and >= %zu bytes of workspace; got %d, %zu\n", (size_t)WS_END, n_in, ws_size); grid = -1; return; }
        int dev = 0, cus = 0, per_cu = 0;
        if (hipGetDevice(&dev) != hipSuccess || hipDeviceGetAttribute(&cus, hipDeviceAttributeMultiprocessorCount, dev) != hipSuccess) { grid = -1; return; }
        if (hipFuncSetAttribute((const void*)mk_fwd, hipFuncAttributeMaxDynamicSharedMemorySize, LDS_BYTES) != hipSuccess) { fprintf(stderr, "kernel_launch: hipFuncSetAttribute failed\n"); grid = -1; return; }
        if (hipOccupancyMaxActiveBlocksPerMultiprocessor(&per_cu, (const void*)mk_fwd, 512, LDS_BYTES) != hipSuccess || per_cu < 1) { fprintf(stderr, "kernel_launch: occupancy query says %d\n", per_cu); per_cu = 1; }
        (void)hipGetLastError();
        grid = cus;
        fprintf(stderr, "kernel_launch: cus %d per_cu %d grid %d ws %zu\n", cus, per_cu, grid, ws_size);
    }
    if (grid < 0) return;
    Args a{};
    for (int i = 0; i < 24; ++i) a.in[i] = (const float*)d_in[i];
    a.out = (float*)d_out; a.ws = (unsigned char*)d_ws;
    a.ph_lo = 0; a.ph_hi = NPH + PROBE_N;
    if (hipMemsetAsync(d_ws, 0, CTL_ZERO_BYTES, stream) != hipSuccess) { fprintf(stderr, "kernel_launch: memset failed\n"); return; }
    hipLaunchKernelGGL(mk_fwd, dim3(grid), dim3(512), LDS_BYTES, stream, a);
}
```

```cpp
#include <hip/hip_runtime.h>
#include <hip/hip_bf16.h>
#include <cstdio>
#include <cstdint>
namespace pg8 {
#define PG8_LAS __attribute__((address_space(3)))
typedef unsigned short bf16_t;
typedef short bf16x8 __attribute__((ext_vector_type(8)));
typedef float f32x4 __attribute__((ext_vector_type(4)));
typedef unsigned u32x4 __attribute__((ext_vector_type(4)));
constexpr int BM = 256, BK = 64, HALF = 128, HTB = HALF * BK * 2  , STAGE_BYTES = 8 * HTB, NXCD = 8, WGM = 4;

__host__ __device__ __forceinline__ int lds_byte(int r, int c) { const int st = (r >> 4) * 2 + (c >> 5), rr = r & 15, cc = c & 31, ob = rr * 64 + cc * 2; return st * 1024 + (ob ^ (((ob >> 9) & 1) << 5)); }
__host__ __device__ __forceinline__ void stage_rc(int b, int& R, int& C) { const int st = b / 1024, sb = b % 1024, swz = sb ^ (((sb >> 9) & 1) << 5); R = (st >> 1) * 16 + swz / 64; C = (st & 1) * 32 + (swz % 64) / 2; }
__host__ __device__ __forceinline__ int perm32(int rho) { const int n = rho >> 4, i = rho & 15; return 8 * (i >> 2) + 4 * n + (i & 3); }

struct Unit { int pm, pn, type; };
struct Gemm { const bf16_t* A; const bf16_t* Bt; int M, N, K, lda; };

struct StaticOrder {
    int nM, nN, nwg, G, c;
    __host__ __device__ void init(int M, int N, int G_, int c_) { nM = M / BM; nN = N / BM; nwg = nM * nN; G = G_; c = c_; }
    __host__ __device__ bool next(int i, Unit& u) const {
        const long L = (long)i * G + c; if (L >= nwg) return false;
        int wgid = (int)L; { const int q = nwg / NXCD, r = nwg % NXCD, xcd = wgid % NXCD, off = wgid / NXCD; wgid = (xcd < r ? xcd * (q + 1) : r * (q + 1) + (xcd - r) * q) + off; }
        const int nig = WGM * nN, gid = wgid / nig, fm = gid * WGM, gsz = (nM - fm) < WGM ? (nM - fm) : WGM;
        u.pm = fm + ((wgid % nig) % gsz); u.pn = (wgid % nig) / gsz; u.type = 0; return true;
    }
    __device__ __forceinline__ void a_ready(const Unit&) const {}
    __device__ __forceinline__ void done(const Unit&) const {}
};

__device__ __forceinline__ unsigned cvt_pk_bf16(float lo, float hi) { unsigned r; asm volatile("v_cvt_pk_bf16_f32 %0, %1, %2" : "=v"(r) : "v"(lo), "v"(hi)); return r; }
typedef float f32x2 __attribute__((ext_vector_type(2)));
template <class Epi, class Sched, bool ALIGN_EPI = false, bool SP2 = false>
__device__ __forceinline__ void gemm_phase(PG8_LAS unsigned char* lds, const Gemm g, const Sched& S, const Epi& E) {
    int tid_ = threadIdx.x; asm volatile("" : "+v"(tid_)); const int tid = tid_, wid = __builtin_amdgcn_readfirstlane(tid >> 6), lane = tid & 63, wr = wid >> 2, wc = wid & 3, fr = lane & 15, fq = lane >> 4;
    const int K = g.K, nt = K / BK;
    unsigned voffA[2], voffB[2];
#pragma unroll
    for (int i = 0; i < 2; ++i) { int R, C; stage_rc(tid * 16 + i * 8192, R, C); const int Rb = Epi::PERM ? ((R & ~31) + perm32(R & 31)) : R;
        voffA[i] = (unsigned)(R * g.lda + C) * 2u; voffB[i] = (unsigned)(Rb * K + C) * 2u; }
    const size_t kstep = (size_t)(BK * 2);
    const size_t hstep = (size_t)HALF * K * 2;
    const size_t tstep = 2 * hstep; const size_t hstepA = (size_t)HALF * g.lda * 2, tstepA = 2 * hstepA;
    const unsigned ldsw = (unsigned)wid * 1024u;
    const int aoff = lds_byte(wr * 64 + fr, fq * 8), boff = lds_byte(wc * 32 + fr, fq * 8);
#define PG8_SA(b, h) (((b) * 2 + (h)) * HTB)
#define PG8_SB(b, h) ((4 + (b) * 2 + (h)) * HTB)
#define PG8_STAGE(bufoff, gbase, voff) do { _Pragma("unroll") for (int _i = 0; _i < 2; ++_i) \
        __builtin_amdgcn_global_load_lds((const unsigned*)((const char*)(gbase) + (voff)[_i]), (PG8_LAS unsigned*)(lds + (bufoff) + ldsw + _i * 8192), 16, 0, 0); } while (0)
#define PG8_LDA(dst, b, h) do { _Pragma("unroll") for (int m = 0; m < 4; ++m) _Pragma("unroll") for (int k = 0; k < 2; ++k) dst[m][k] = *(const PG8_LAS bf16x8*)(lds + PG8_SA(b, h) + aoff + m * 2048 + k * 1024); } while (0)
#define PG8_LDB(dst, b, h) do { _Pragma("unroll") for (int n = 0; n < 2; ++n) _Pragma("unroll") for (int k = 0; k < 2; ++k) dst[n][k] = *(const PG8_LAS bf16x8*)(lds + PG8_SB(b, h) + boff + n * 2048 + k * 1024); } while (0)
#define PG8_MMA(ai, bj, At, Bt) do { __builtin_amdgcn_s_setprio(1); _Pragma("unroll") for (int m = 0; m < 4; ++m) _Pragma("unroll") for (int n = 0; n < 2; ++n) _Pragma("unroll") for (int k = 0; k < 2; ++k) \
        acc[ai][bj][m][n] = __builtin_amdgcn_mfma_f32_16x16x32_bf16(Bt[n][k], At[m][k], acc[ai][bj][m][n], 0, 0, 0); __builtin_amdgcn_s_setprio(0); } while (0)
#define PG8_WAIT_V(n) asm volatile("s_waitcnt vmcnt(" #n ")" ::: "memory")
#define PG8_WAIT_L(n) asm volatile("s_waitcnt lgkmcnt(" #n ")" ::: "memory")
#define PG8_BAR __builtin_amdgcn_s_barrier()
#define PG8_SCHED __builtin_amdgcn_sched_barrier(0)
    Unit cur, nxt; int ui = 0;
    if (!S.next(0, cur)) return;
    f32x4 acc[2][2][4][2];
#pragma unroll
    for (int a = 0; a < 2; ++a)
#pragma unroll
        for (int b = 0; b < 2; ++b)
#pragma unroll
            for (int m = 0; m < 4; ++m)
#pragma unroll
                for (int n = 0; n < 2; ++n) acc[a][b][m][n] = (f32x4){0.f, 0.f, 0.f, 0.f};
    bf16x8 At[4][2], B0[2][2], B1[2][2];
    const char* cA = (const char*)g.A + (size_t)cur.pm * tstepA; const char* cB = (const char*)g.Bt + (size_t)cur.pn * tstep;
    S.a_ready(cur);
    if constexpr (SP2) {
        PG8_STAGE(PG8_SB(0, 0), cB, voffB); PG8_STAGE(PG8_SB(0, 1), cB + hstep, voffB); PG8_STAGE(PG8_SA(0, 0), cA, voffA); PG8_STAGE(PG8_SA(0, 1), cA + hstepA, voffA);
        if (wr == 1) PG8_BAR;
        PG8_WAIT_V(2); PG8_BAR;
        PG8_STAGE(PG8_SB(1, 0), cB + kstep, voffB); PG8_STAGE(PG8_SA(1, 0), cA + kstep, voffA); PG8_STAGE(PG8_SB(1, 1), cB + hstep + kstep, voffB);
        PG8_WAIT_V(6); PG8_BAR;
    } else {
        PG8_STAGE(PG8_SB(0, 0), cB, voffB); PG8_STAGE(PG8_SA(0, 0), cA, voffA); PG8_STAGE(PG8_SB(0, 1), cB + hstep, voffB); PG8_STAGE(PG8_SA(0, 1), cA + hstepA, voffA);
        if (wr == 1) PG8_BAR;
        PG8_WAIT_V(4); PG8_BAR;
        PG8_STAGE(PG8_SB(1, 0), cB + kstep, voffB); PG8_STAGE(PG8_SA(1, 0), cA + kstep, voffA); PG8_STAGE(PG8_SB(1, 1), cB + hstep + kstep, voffB);
        PG8_WAIT_V(6); PG8_BAR;
    }
    for (;;) {
        const bool has_next = S.next(ui + 1, nxt);
        const char* nA = has_next ? (const char*)g.A + (size_t)nxt.pm * tstepA : cA; const char* nB = has_next ? (const char*)g.Bt + (size_t)nxt.pn * tstep : cB;
        for (int t = 0; t < nt; t += 2) {
            const bool last = (t == nt - 2);
            const char* a1 = cA + (size_t)(t + 1) * kstep;
            const char* a2 = last ? nA : cA + (size_t)(t + 2) * kstep; const char* b2 = last ? nB : cB + (size_t)(t + 2) * kstep;
            const char* a3 = a2 + kstep; const char* b3 = b2 + kstep;
            if (last && has_next) S.a_ready(nxt);
            if constexpr (SP2) {
            PG8_LDB(B0, 0, 0); PG8_LDB(B1, 0, 1); PG8_SCHED; PG8_LDA(At, 0, 0); PG8_STAGE(PG8_SA(1, 1), a1 + hstepA, voffA);
            PG8_WAIT_V(8); PG8_WAIT_L(0); PG8_BAR; PG8_MMA(0, 0, At, B0); PG8_MMA(0, 1, At, B1); PG8_BAR; PG8_SCHED;
            PG8_LDA(At, 0, 1); PG8_STAGE(PG8_SB(0, 0), b2, voffB); PG8_STAGE(PG8_SB(0, 1), b2 + hstep, voffB); PG8_STAGE(PG8_SA(0, 0), a2, voffA);
            PG8_WAIT_V(8); PG8_WAIT_L(0); PG8_BAR; PG8_MMA(1, 0, At, B0); PG8_MMA(1, 1, At, B1); PG8_BAR; PG8_SCHED;
            PG8_LDB(B0, 1, 0); PG8_LDB(B1, 1, 1); PG8_SCHED; PG8_LDA(At, 1, 0); PG8_STAGE(PG8_SA(0, 1), a2 + hstepA, voffA);
            PG8_WAIT_V(8); PG8_WAIT_L(0); PG8_BAR; PG8_MMA(0, 0, At, B0); PG8_MMA(0, 1, At, B1); PG8_BAR; PG8_SCHED;
            PG8_LDA(At, 1, 1); PG8_STAGE(PG8_SB(1, 0), b3, voffB); PG8_STAGE(PG8_SB(1, 1), b3 + hstep, voffB); PG8_STAGE(PG8_SA(1, 0), a3, voffA);
            PG8_WAIT_V(8); PG8_WAIT_L(0); PG8_BAR; PG8_MMA(1, 0, At, B0); PG8_MMA(1, 1, At, B1); PG8_BAR; PG8_SCHED;
            } else {
            PG8_LDB(B0, 0, 0); PG8_SCHED; PG8_LDA(At, 0, 0); PG8_STAGE(PG8_SA(1, 1), a1 + hstepA, voffA);
            PG8_WAIT_L(8); PG8_BAR; PG8_WAIT_L(0); PG8_MMA(0, 0, At, B0); PG8_BAR; PG8_SCHED;
            PG8_LDB(B1, 0, 1); PG8_STAGE(PG8_SB(0, 0), b2, voffB);
            PG8_BAR; PG8_WAIT_L(0); PG8_MMA(0, 1, At, B1); PG8_BAR;
            PG8_LDA(At, 0, 1); PG8_STAGE(PG8_SA(0, 0), a2, voffA);
            PG8_BAR; PG8_WAIT_L(0); PG8_MMA(1, 0, At, B0); PG8_BAR; PG8_SCHED;
            PG8_STAGE(PG8_SB(0, 1), b2 + hstep, voffB);
            PG8_WAIT_V(6); PG8_BAR; PG8_MMA(1, 1, At, B1); PG8_BAR;
            PG8_LDB(B0, 1, 0); PG8_SCHED; PG8_LDA(At, 1, 0); PG8_STAGE(PG8_SA(0, 1), a2 + hstepA, voffA);
            PG8_WAIT_L(8); PG8_BAR; PG8_WAIT_L(0); PG8_MMA(0, 0, At, B0); PG8_BAR; PG8_SCHED;
            PG8_LDB(B1, 1, 1); PG8_STAGE(PG8_SB(1, 0), b3, voffB);
            PG8_BAR; PG8_WAIT_L(0); PG8_MMA(0, 1, At, B1); PG8_BAR;
            PG8_LDA(At, 1, 1); PG8_STAGE(PG8_SA(1, 0), a3, voffA);
            PG8_BAR; PG8_WAIT_L(0); PG8_MMA(1, 0, At, B0); PG8_BAR; PG8_SCHED;
            PG8_STAGE(PG8_SB(1, 1), b3 + hstep, voffB);
            PG8_WAIT_V(6); PG8_BAR; PG8_MMA(1, 1, At, B1); PG8_BAR;
            }
        }
        if constexpr (ALIGN_EPI) { if (wr == 0) PG8_BAR; }
        if constexpr (!Epi::AFTER_DRAIN) { int t2_ = threadIdx.x; asm volatile("" : "+v"(t2_)); E(acc, cur, wr, wc, t2_ & 15, (t2_ & 63) >> 4); S.done(cur); }
        if (!has_next) break;
#pragma unroll
        for (int a = 0; a < 2; ++a)
#pragma unroll
            for (int b = 0; b < 2; ++b)
#pragma unroll
                for (int m = 0; m < 4; ++m)
#pragma unroll
                    for (int n = 0; n < 2; ++n) acc[a][b][m][n] = (f32x4){0.f, 0.f, 0.f, 0.f};
        cur = nxt; cA = nA; cB = nB; ++ui;
        if constexpr (ALIGN_EPI) { if (wr == 1) PG8_BAR; }
    }
    PG8_WAIT_V(0);
    if constexpr (!ALIGN_EPI) { if (wr == 0) PG8_BAR; }
    PG8_BAR;
    if constexpr (Epi::AFTER_DRAIN) { E.fused(acc, cur, wr, wc, fr, fq, lds, wid, lane); S.done(cur); }
#undef PG8_SA
#undef PG8_SB
#undef PG8_STAGE
#undef PG8_LDA
#undef PG8_LDB
#undef PG8_MMA
#undef PG8_WAIT_V
#undef PG8_WAIT_L
#undef PG8_BAR
#undef PG8_SCHED
}
}
namespace pg8 {
constexpr size_t KB_OFF = (size_t)373 << 20, VB_OFF = (size_t)380 << 20, ROPE_OFF = 64 * 1024, SK_OFF = (size_t)12288 * 2048, SV_OFF = SK_OFF + 16 * 2 * 256 * 256;
typedef unsigned u32x2e __attribute__((ext_vector_type(2)));
__device__ __forceinline__ float e_lo(unsigned u) { return __uint_as_float(u << 16); }
__device__ __forceinline__ float e_hi(unsigned u) { return __uint_as_float(u & 0xffff0000u); }
__device__ __forceinline__ float e_sig(float x) { return fminf(__expf(-x), 1e30f); }
struct EpiProj {
    static constexpr bool PERM = true, AFTER_DRAIN = false;
    bf16_t* proj; bf16_t* gates; const float* bmerge; int skip; int pn_off;
    unsigned char* ws; float* out; const float* qnw; const float* knw; int l; PG8_LAS float* red;
    __device__ __forceinline__ void head_tiles(const f32x4 (&acc)[2][2][4][2], const Unit& u, int pnn, int wr, int wc, int fr, int fq) const {
        const int rowt = u.pm * BM; const bool lat = rowt >= 4096;
        const int bb = lat ? ((rowt - 4096) >> 11) : (rowt >> 8);
        const int t0 = lat ? ((rowt - 4096) & 2047) : 0;
        const size_t kv0 = lat ? (size_t)4096 + (size_t)bb * 2304 + t0 : (size_t)rowt;
        bf16_t* KB = (bf16_t*)(ws + KB_OFF); bf16_t* VB = (bf16_t*)(ws + VB_OFF);
        if (pnn == 5) {
#pragma unroll
            for (int ai = 0; ai < 2; ++ai)
#pragma unroll
                for (int m = 0; m < 4; ++m) { const int rl = ai * HALF + wr * 64 + m * 16 + fr;
#pragma unroll
                    for (int bj = 0; bj < 2; ++bj) { const int c = bj * HALF + wc * 32 + 8 * fq; const f32x4 v0 = acc[ai][bj][m][0], v1 = acc[ai][bj][m][1];
                        u32x4 w; w.x = cvt_pk_bf16(v0[0], v0[1]); w.y = cvt_pk_bf16(v0[2], v0[3]); w.z = cvt_pk_bf16(v1[0], v1[1]); w.w = cvt_pk_bf16(v1[2], v1[3]);
                        *(u32x4*)(VB + (kv0 + rl) * 256 + c) = w;
                        if (!lat) { float* sv = out + SV_OFF + ((size_t)(bb * 2 + l) * 256 + rl) * 256 + c; *(f32x4*)sv = v0; *(f32x4*)(sv + 4) = v1; } } }
            return; }
        const bool isk = pnn == 4; const float* nw = isk ? knw : qnw;
#pragma unroll
        for (int ai = 0; ai < 2; ++ai)
#pragma unroll
            for (int m = 0; m < 4; ++m) { const int rl = ai * HALF + wr * 64 + m * 16 + fr;
#pragma unroll
                for (int bj = 0; bj < 2; ++bj) { const f32x4 a = acc[ai][bj][m][0], b = acc[ai][bj][m][1];
                    float ss = (a[0] * a[0] + a[1] * a[1]) + (a[2] * a[2] + a[3] * a[3]) + (b[0] * b[0] + b[1] * b[1]) + (b[2] * b[2] + b[3] * b[3]);
                    ss += __shfl_xor(ss, 16); ss += __shfl_xor(ss, 32);
                    if (fq == 0) red[(rl * 2 + bj) * 4 + wc] = ss; } }
        asm volatile("s_waitcnt lgkmcnt(0)" ::: "memory"); __builtin_amdgcn_s_barrier(); asm volatile("" ::: "memory");
        const int q0 = 4 * (4 * wc + fq), base = q0 < 32 ? q0 : q0 + 32;
        const f32x4 w0 = *(const f32x4*)(nw + base), w1 = *(const f32x4*)(nw + base + 32);
        const float* tab = (const float*)(ws + ROPE_OFF);
#pragma unroll
        for (int ai = 0; ai < 2; ++ai)
#pragma unroll
            for (int m = 0; m < 4; ++m) { const int rl = ai * HALF + wr * 64 + m * 16 + fr; const int t = t0 + rl;
                f32x4 cs = {1.f, 1.f, 1.f, 1.f}, sn = {0.f, 0.f, 0.f, 0.f};
                if (lat) { const int pos = q0 < 32 ? (t >> 6) : (t & 63); const float* tp = tab + (size_t)(pos * 32 + (q0 & 31)) * 2;
                    const f32x4 c0 = *(const f32x4*)tp, c1 = *(const f32x4*)(tp + 4); cs = (f32x4){c0[0], c0[2], c1[0], c1[2]}; sn = (f32x4){c0[1], c0[3], c1[1], c1[3]}; }
#pragma unroll
                for (int bj = 0; bj < 2; ++bj) { const f32x4 pr = *(const PG8_LAS f32x4*)(red + (rl * 2 + bj) * 4);
                    const float rstd = 1.f / sqrtf(((pr[0] + pr[1]) + (pr[2] + pr[3])) * (1.f / 128.f) + 1e-6f);
                    f32x4 y0 = acc[ai][bj][m][0] * rstd * w0, y1 = acc[ai][bj][m][1] * rstd * w1;
                    const int hc = bj * HALF + wc * 32 + 8 * fq;
                    if (isk && !lat) { float* sk = out + SK_OFF + ((size_t)(bb * 2 + l) * 256 + rl) * 256 + bj * HALF + base; *(f32x4*)sk = y0; *(f32x4*)(sk + 32) = y1; }
                    const f32x4 o0 = y0 * cs - y1 * sn, o1 = y1 * cs + y0 * sn;
                    u32x4 w; w.x = cvt_pk_bf16(o0[0], o0[1]); w.y = cvt_pk_bf16(o0[2], o0[3]); w.z = cvt_pk_bf16(o1[0], o1[1]); w.w = cvt_pk_bf16(o1[2], o1[3]);
                    if (isk) *(u32x4*)(KB + (kv0 + rl) * 256 + hc) = w;
                    else *(u32x4*)(proj + (size_t)(rowt + rl) * 5120 + pnn * BM + hc) = w; } }
        asm volatile("s_waitcnt lgkmcnt(0)" ::: "memory"); __builtin_amdgcn_s_barrier(); asm volatile("" ::: "memory");
    }
    __device__ __forceinline__ void operator()(const f32x4 (&acc)[2][2][4][2], const Unit& u, int wr, int wc, int fr, int fq) const {
        if (skip) return;
        const int pnn = u.pn + pn_off; const int row0 = u.pm * BM + wr * 64 + fr; const bool isg = pnn >= 20;
        if (pnn < 6) { head_tiles(acc, u, pnn, wr, wc, fr, fq); return; }
        const int colt = (isg ? pnn - 20 : pnn) * BM; const int ld = isg ? 6144 : 5120; bf16_t* base = isg ? gates : proj;
        const int col0 = colt + wc * 32 + 8 * fq;
        f32x4 bv[2][2];
#pragma unroll
        for (int bj = 0; bj < 2; ++bj)
#pragma unroll
            for (int n = 0; n < 2; ++n) bv[bj][n] = isg ? *(const f32x4*)(bmerge + col0 + bj * HALF + 4 * n) : (f32x4){0.f, 0.f, 0.f, 0.f};
#pragma unroll
        for (int ai = 0; ai < 2; ++ai)
#pragma unroll
            for (int m = 0; m < 4; ++m) { bf16_t* rowp = base + (size_t)(row0 + ai * HALF + m * 16) * ld + col0;
                bf16_t* fragp = gates + ((((size_t)u.pm * 24 + (pnn - 20)) * 16 + (ai * 8 + m * 2)) * 512 + ((wr * 4 + wc) * 64 + fq * 16 + fr)) * 8;
#pragma unroll
                for (int bj = 0; bj < 2; ++bj) { f32x4 v0 = acc[ai][bj][m][0] + bv[bj][0], v1 = acc[ai][bj][m][1] + bv[bj][1];
                    if (isg) { v0 = (f32x4){e_sig(v0[0]), e_sig(v0[1]), e_sig(v0[2]), e_sig(v0[3])}; v1 = (f32x4){e_sig(v1[0]), e_sig(v1[1]), e_sig(v1[2]), e_sig(v1[3])}; }
                    u32x4 w; w.x = cvt_pk_bf16(v0[0], v0[1]); w.y = cvt_pk_bf16(v0[2], v0[3]); w.z = cvt_pk_bf16(v1[0], v1[1]); w.w = cvt_pk_bf16(v1[2], v1[3]);
                    if (isg) __builtin_nontemporal_store(w, (u32x4*)(fragp + bj * 4096)); else __builtin_nontemporal_store(w, (u32x4*)(rowp + bj * HALF)); } }
    }
};
struct EpiBranch {
    static constexpr bool PERM = true, AFTER_DRAIN = false;
    bf16_t* merged; const bf16_t* gates; int first;
    __device__ __forceinline__ void operator()(const f32x4 (&acc)[2][2][4][2], const Unit& u, int wr, int wc, int fr, int fq) const {
        const int row0 = u.pm * BM + wr * 64 + fr; const int col0 = u.pn * BM + wc * 32 + 8 * fq;
#pragma unroll
        for (int ai = 0; ai < 2; ++ai)
#pragma unroll
            for (int m = 0; m < 4; ++m) { const size_t row = (size_t)(row0 + ai * HALF + m * 16);
#pragma unroll
                for (int bj = 0; bj < 2; ++bj) { const u32x4 g = *(const u32x4*)(gates + row * 6144 + col0 + bj * HALF); bf16_t* mp = merged + row * 2048 + col0 + bj * HALF;
                    f32x4 v0 = acc[ai][bj][m][0], v1 = acc[ai][bj][m][1];
                    v0 = v0 * (f32x4){e_lo(g.x), e_hi(g.x), e_lo(g.y), e_hi(g.y)}; v1 = v1 * (f32x4){e_lo(g.z), e_hi(g.z), e_lo(g.w), e_hi(g.w)};
                    if (!first) { const u32x4 o = *(const u32x4*)mp; v0 = v0 + (f32x4){e_lo(o.x), e_hi(o.x), e_lo(o.y), e_hi(o.y)}; v1 = v1 + (f32x4){e_lo(o.z), e_hi(o.z), e_lo(o.w), e_hi(o.w)}; }
                    u32x4 w; w.x = cvt_pk_bf16(v0[0], v0[1]); w.y = cvt_pk_bf16(v0[2], v0[3]); w.z = cvt_pk_bf16(v1[0], v1[1]); w.w = cvt_pk_bf16(v1[2], v1[3]);
                    *(u32x4*)mp = w; } }
    }
};
struct EpiResid {
    static constexpr bool PERM = false, AFTER_DRAIN = false;
    const float* xc; const float* xl; float* out; const float* mod;
    __device__ __forceinline__ void operator()(const f32x4 (&acc)[2][2][4][2], const Unit& u, int wr, int wc, int fr, int fq) const {
        const int rowt = u.pm * BM; const int col0 = u.pn * BM + wc * 32 + 4 * fq;
        const float* gate = mod + ((rowt < 4096) ? 0 : 1 + ((rowt - 4096) >> 11)) * 6144 + 4096;
        const float* xo = (rowt < 4096) ? xc : xl - (size_t)4096 * 2048;
        f32x4 gv[2][2];
#pragma unroll
        for (int bj = 0; bj < 2; ++bj)
#pragma unroll
            for (int n = 0; n < 2; ++n) gv[bj][n] = *(const f32x4*)(gate + col0 + bj * HALF + n * 16);
#pragma unroll
        for (int ai = 0; ai < 2; ++ai)
#pragma unroll
            for (int m = 0; m < 4; ++m) { const size_t off = (size_t)(rowt + ai * HALF + wr * 64 + m * 16 + fr) * 2048 + col0;
#pragma unroll
                for (int bj = 0; bj < 2; ++bj)
#pragma unroll
                    for (int n = 0; n < 2; ++n) { const f32x4 xv = *(const f32x4*)(xo + off + bj * HALF + n * 16);
                        *(f32x4*)(out + off + bj * HALF + n * 16) = xv + gv[bj][n] * acc[ai][bj][m][n]; } }
    }
};
struct DeferOrder {
    int G, c;
    __device__ __forceinline__ bool next(int i, Unit& u) const {
        if (G == 256) { const int x = c & 7, j = (c >> 3) + 32 * i; if (j >= 40) return false;
            u.pm = 5 * x + (j >> 3); u.pn = j & 7; u.type = 0; return true; }
        const long t = (long)i * G + c; if (t >= 320) return false; u.pm = (int)(t >> 3); u.pn = (int)(t & 7); u.type = 0; return true; }
    __device__ __forceinline__ void a_ready(const Unit&) const {}
    __device__ __forceinline__ void done(const Unit&) const {}
};
struct Gemm1Order {
    StaticOrder so; int G, c;
    __device__ __forceinline__ void init(int M, int N, int G_, int c_) { so.init(M, N, G_, c_); G = G_; c = c_; }
    __device__ __forceinline__ bool next(int i, Unit& u) const { const long L = (long)i * G + c; if (L < so.nwg) return so.next(i, u); const long e = L - so.nwg; if (e >= 64) return false;
        u.pm = 40 + (int)(e >> 3); u.pn = 36 + (int)(e & 7); u.type = 0; return true; }
    __device__ __forceinline__ void a_ready(const Unit&) const {}
    __device__ __forceinline__ void done(const Unit&) const {}
};
}
namespace pg8 {
struct Gemm2 { const bf16_t* A0; const bf16_t* B0; const bf16_t* A1; const bf16_t* B1; int M, N, K, lda; };
template <class Epi, class Sched, bool ALIGN_EPI = false, bool SP2 = false>
__device__ __forceinline__ void gemm_fused(PG8_LAS unsigned char* lds, const Gemm2 g, const Sched& S, const Epi& E) {
    int tid_ = threadIdx.x; asm volatile("" : "+v"(tid_)); const int tid = tid_, wid = __builtin_amdgcn_readfirstlane(tid >> 6), lane = tid & 63, wr = wid >> 2, wc = wid & 3, fr = lane & 15, fq = lane >> 4;
    const int K = g.K, nt = K / BK;
    unsigned voffA[2], voffB[2];
#pragma unroll
    for (int i = 0; i < 2; ++i) { int R, C; stage_rc(tid * 16 + i * 8192, R, C); const int Rb = Epi::PERM ? ((R & ~31) + perm32(R & 31)) : R;
        voffA[i] = (unsigned)(R * g.lda + C) * 2u; voffB[i] = (unsigned)(Rb * K + C) * 2u; }
    const size_t kstep = (size_t)(BK * 2);
    const size_t hstep = (size_t)HALF * K * 2;
    const size_t tstep = 2 * hstep; const size_t hstepA = (size_t)HALF * g.lda * 2, tstepA = 2 * hstepA;
    const unsigned ldsw = (unsigned)wid * 1024u;
    const int aoff = lds_byte(wr * 64 + fr, fq * 8), boff = lds_byte(wc * 32 + fr, fq * 8);
#define PG8_SA(b, h) (((b) * 2 + (h)) * HTB)
#define PG8_SB(b, h) ((4 + (b) * 2 + (h)) * HTB)
#define PG8_STAGE(bufoff, gbase, voff) do { _Pragma("unroll") for (int _i = 0; _i < 2; ++_i) \
        __builtin_amdgcn_global_load_lds((const unsigned*)((const char*)(gbase) + (voff)[_i]), (PG8_LAS unsigned*)(lds + (bufoff) + ldsw + _i * 8192), 16, 0, 0); } while (0)
#define PG8_LDA(dst, b, h) do { _Pragma("unroll") for (int m = 0; m < 4; ++m) _Pragma("unroll") for (int k = 0; k < 2; ++k) dst[m][k] = *(const PG8_LAS bf16x8*)(lds + PG8_SA(b, h) + aoff + m * 2048 + k * 1024); } while (0)
#define PG8_LDB(dst, b, h) do { _Pragma("unroll") for (int n = 0; n < 2; ++n) _Pragma("unroll") for (int k = 0; k < 2; ++k) dst[n][k] = *(const PG8_LAS bf16x8*)(lds + PG8_SB(b, h) + boff + n * 2048 + k * 1024); } while (0)
#define PG8_MMA(ai, bj, At, Bt) do { __builtin_amdgcn_s_setprio(1); _Pragma("unroll") for (int m = 0; m < 4; ++m) _Pragma("unroll") for (int n = 0; n < 2; ++n) _Pragma("unroll") for (int k = 0; k < 2; ++k) \
        acc[ai][bj][m][n] = __builtin_amdgcn_mfma_f32_16x16x32_bf16(Bt[n][k], At[m][k], acc[ai][bj][m][n], 0, 0, 0); __builtin_amdgcn_s_setprio(0); } while (0)
#define PG8_WAIT_V(n) asm volatile("s_waitcnt vmcnt(" #n ")" ::: "memory")
#define PG8_WAIT_L(n) asm volatile("s_waitcnt lgkmcnt(" #n ")" ::: "memory")
#define PG8_BAR __builtin_amdgcn_s_barrier()
#define PG8_SCHED __builtin_amdgcn_sched_barrier(0)
    Unit cur, nxt; int ui = 0;
    if (!S.next(0, cur)) return;
    f32x4 acc[2][2][4][2];
#pragma unroll
    for (int a = 0; a < 2; ++a)
#pragma unroll
        for (int b = 0; b < 2; ++b)
#pragma unroll
            for (int m = 0; m < 4; ++m)
#pragma unroll
                for (int n = 0; n < 2; ++n) acc[a][b][m][n] = (f32x4){0.f, 0.f, 0.f, 0.f};
    bf16x8 At[4][2], B0[2][2], B1[2][2];
    const char* cA = (const char*)(cur.type ? g.A1 : g.A0) + (size_t)cur.pm * tstepA; const char* cB = (const char*)(cur.type ? g.B1 : g.B0) + (size_t)cur.pn * tstep;
    S.a_ready(cur);
    if constexpr (SP2) {
        PG8_STAGE(PG8_SB(0, 0), cB, voffB); PG8_STAGE(PG8_SB(0, 1), cB + hstep, voffB); PG8_STAGE(PG8_SA(0, 0), cA, voffA); PG8_STAGE(PG8_SA(0, 1), cA + hstepA, voffA);
        if (wr == 1) PG8_BAR;
        PG8_WAIT_V(2); PG8_BAR;
        PG8_STAGE(PG8_SB(1, 0), cB + kstep, voffB); PG8_STAGE(PG8_SA(1, 0), cA + kstep, voffA); PG8_STAGE(PG8_SB(1, 1), cB + hstep + kstep, voffB);
        PG8_WAIT_V(6); PG8_BAR;
    } else {
        PG8_STAGE(PG8_SB(0, 0), cB, voffB); PG8_STAGE(PG8_SA(0, 0), cA, voffA); PG8_STAGE(PG8_SB(0, 1), cB + hstep, voffB); PG8_STAGE(PG8_SA(0, 1), cA + hstepA, voffA);
        if (wr == 1) PG8_BAR;
        PG8_WAIT_V(4); PG8_BAR;
        PG8_STAGE(PG8_SB(1, 0), cB + kstep, voffB); PG8_STAGE(PG8_SA(1, 0), cA + kstep, voffA); PG8_STAGE(PG8_SB(1, 1), cB + hstep + kstep, voffB);
        PG8_WAIT_V(6); PG8_BAR;
    }
    for (;;) {
        const bool has_next = S.next(ui + 1, nxt);
        const char* nA = has_next ? (const char*)(nxt.type ? g.A1 : g.A0) + (size_t)nxt.pm * tstepA : cA; const char* nB = has_next ? (const char*)(nxt.type ? g.B1 : g.B0) + (size_t)nxt.pn * tstep : cB;
        for (int t = 0; t < nt; t += 2) {
            const bool last = (t == nt - 2);
            const char* a1 = cA + (size_t)(t + 1) * kstep;
            const char* a2 = last ? nA : cA + (size_t)(t + 2) * kstep; const char* b2 = last ? nB : cB + (size_t)(t + 2) * kstep;
            const char* a3 = a2 + kstep; const char* b3 = b2 + kstep;
            if (last && has_next) S.a_ready(nxt);
            if constexpr (SP2) {
            PG8_LDB(B0, 0, 0); PG8_LDB(B1, 0, 1); PG8_SCHED; PG8_LDA(At, 0, 0); PG8_STAGE(PG8_SA(1, 1), a1 + hstepA, voffA);
            PG8_WAIT_V(8); PG8_WAIT_L(0); PG8_BAR; PG8_MMA(0, 0, At, B0); PG8_MMA(0, 1, At, B1); PG8_BAR; PG8_SCHED;
            PG8_LDA(At, 0, 1); PG8_STAGE(PG8_SB(0, 0), b2, voffB); PG8_STAGE(PG8_SB(0, 1), b2 + hstep, voffB); PG8_STAGE(PG8_SA(0, 0), a2, voffA);
            PG8_WAIT_V(8); PG8_WAIT_L(0); PG8_BAR; PG8_MMA(1, 0, At, B0); PG8_MMA(1, 1, At, B1); PG8_BAR; PG8_SCHED;
            PG8_LDB(B0, 1, 0); PG8_LDB(B1, 1, 1); PG8_SCHED; PG8_LDA(At, 1, 0); PG8_STAGE(PG8_SA(0, 1), a2 + hstepA, voffA);
            PG8_WAIT_V(8); PG8_WAIT_L(0); PG8_BAR; PG8_MMA(0, 0, At, B0); PG8_MMA(0, 1, At, B1); PG8_BAR; PG8_SCHED;
            PG8_LDA(At, 1, 1); PG8_STAGE(PG8_SB(1, 0), b3, voffB); PG8_STAGE(PG8_SB(1, 1), b3 + hstep, voffB); PG8_STAGE(PG8_SA(1, 0), a3, voffA);
            PG8_WAIT_V(8); PG8_WAIT_L(0); PG8_BAR; PG8_MMA(1, 0, At, B0); PG8_MMA(1, 1, At, B1); PG8_BAR; PG8_SCHED;
            } else {
            PG8_LDB(B0, 0, 0); PG8_SCHED; PG8_LDA(At, 0, 0); PG8_STAGE(PG8_SA(1, 1), a1 + hstepA, voffA);
            PG8_WAIT_L(8); PG8_BAR; PG8_WAIT_L(0); PG8_MMA(0, 0, At, B0); PG8_BAR; PG8_SCHED;
            PG8_LDB(B1, 0, 1); PG8_STAGE(PG8_SB(0, 0), b2, voffB);
            PG8_BAR; PG8_WAIT_L(0); PG8_MMA(0, 1, At, B1); PG8_BAR;
            PG8_LDA(At, 0, 1); PG8_STAGE(PG8_SA(0, 0), a2, voffA);
            PG8_BAR; PG8_WAIT_L(0); PG8_MMA(1, 0, At, B0); PG8_BAR; PG8_SCHED;
            PG8_STAGE(PG8_SB(0, 1), b2 + hstep, voffB);
            PG8_WAIT_V(6); PG8_BAR; PG8_MMA(1, 1, At, B1); PG8_BAR;
            PG8_LDB(B0, 1, 0); PG8_SCHED; PG8_LDA(At, 1, 0); PG8_STAGE(PG8_SA(0, 1), a2 + hstepA, voffA);
            PG8_WAIT_L(8); PG8_BAR; PG8_WAIT_L(0); PG8_MMA(0, 0, At, B0); PG8_BAR; PG8_SCHED;
            PG8_LDB(B1, 1, 1); PG8_STAGE(PG8_SB(1, 0), b3, voffB);
            PG8_BAR; PG8_WAIT_L(0); PG8_MMA(0, 1, At, B1); PG8_BAR;
            PG8_LDA(At, 1, 1); PG8_STAGE(PG8_SA(1, 0), a3, voffA);
            PG8_BAR; PG8_WAIT_L(0); PG8_MMA(1, 0, At, B0); PG8_BAR; PG8_SCHED;
            PG8_STAGE(PG8_SB(1, 1), b3 + hstep, voffB);
            PG8_WAIT_V(6); PG8_BAR; PG8_MMA(1, 1, At, B1); PG8_BAR;
            }
            if (cur.type == 0 && (t == 14 || t == 22)) { int t3_ = threadIdx.x; asm volatile("" : "+v"(t3_)); E.mid(acc, cur, wr, wc, t3_ & 15, (t3_ & 63) >> 4, t == 14 ? 0 : 1); }
        }
        if constexpr (ALIGN_EPI) { if (wr == 0) PG8_BAR; }
        if constexpr (!Epi::AFTER_DRAIN) { int t2_ = threadIdx.x; asm volatile("" : "+v"(t2_)); E(acc, cur, wr, wc, t2_ & 15, (t2_ & 63) >> 4); S.done(cur); }
        if (!has_next) break;
#pragma unroll
        for (int a = 0; a < 2; ++a)
#pragma unroll
            for (int b = 0; b < 2; ++b)
#pragma unroll
                for (int m = 0; m < 4; ++m)
#pragma unroll
                    for (int n = 0; n < 2; ++n) acc[a][b][m][n] = (f32x4){0.f, 0.f, 0.f, 0.f};
        cur = nxt; cA = nA; cB = nB; ++ui;
        if constexpr (ALIGN_EPI) { if (wr == 1) PG8_BAR; }
    }
    PG8_WAIT_V(0);
    if constexpr (!ALIGN_EPI) { if (wr == 0) PG8_BAR; }
    PG8_BAR;
    if constexpr (Epi::AFTER_DRAIN) { E.fused(acc, cur, wr, wc, fr, fq, lds, wid, lane); S.done(cur); }
#undef PG8_SA
#undef PG8_SB
#undef PG8_STAGE
#undef PG8_LDA
#undef PG8_LDB
#undef PG8_MMA
#undef PG8_WAIT_V
#undef PG8_WAIT_L
#undef PG8_BAR
#undef PG8_SCHED
}
}
namespace pg8 {
__device__ __forceinline__ void store16_sc1(void* p, u32x4 v) { asm volatile("global_store_dwordx4 %0, %1, off sc1" :: "v"(p), "v"(v) : "memory"); }
#ifndef MK_WT
#define MK_WT 1
#endif
#if MK_WT
#define MK_ST16(p, v) store16_sc1((p), (v))
#define MK_PUBLISH_FENCE do {} while (0)
#else
#define MK_ST16(p, v) (*(u32x4*)(p) = (v))
#define MK_PUBLISH_FENCE __builtin_amdgcn_fence(__ATOMIC_RELEASE, "agent")
#endif
struct FusedOrder {
    int G, c; unsigned* cnt;
    __device__ __forceinline__ bool next(int i, Unit& u) const {
        if (G == 256) { if (i >= 3) return false; const int h = c >> 7, idx = c & 127, x = idx & 7, j = idx >> 3;
            u.type = (i == 0) ? 0 : (i == 1 ? h : 1);
            const int p0 = (i == 0) ? 16 * h : (i == 1 ? (h ? 0 : 32) : (h ? 32 : 16));
            u.pm = p0 + 4 * (x >> 1) + (j >> 2); u.pn = 4 * (x & 1) + (j & 3); return true; }
        const long L = (long)i * G + c; if (L >= 768) return false;
        u.type = L >= 384; const int t = (int)(L % 384); u.pm = t >> 3; u.pn = t & 7; return true;
    }
    __device__ __forceinline__ void a_ready(const Unit& u) const {
        if (u.type == 0) return;
        if (threadIdx.x < 64) {
            unsigned polls = 0;
            while ((unsigned)__builtin_amdgcn_readfirstlane(__hip_atomic_load(cnt + 64 * u.pm, __ATOMIC_RELAXED, __HIP_MEMORY_SCOPE_AGENT)) < 8u) {
                if (++polls > (1u << 20)) break;
                __builtin_amdgcn_s_sleep(2); }
            __builtin_amdgcn_fence(__ATOMIC_ACQUIRE, "agent");
            asm volatile("s_waitcnt vmcnt(0)" ::: "memory");
        }
        asm volatile("" ::: "memory"); __builtin_amdgcn_s_barrier(); asm volatile("" ::: "memory");
    }
    __device__ __forceinline__ void done(const Unit& u) const {
        if (u.type != 0) return;
        asm volatile("s_waitcnt vmcnt(0)" ::: "memory");
        __builtin_amdgcn_s_barrier(); asm volatile("" ::: "memory");
        if (threadIdx.x < 64) {
            __builtin_amdgcn_fence(__ATOMIC_RELEASE, "agent");
            asm volatile("s_waitcnt vmcnt(0)" ::: "memory");
            if (threadIdx.x == 0) __hip_atomic_fetch_add(cnt + 64 * u.pm, 1u, __ATOMIC_RELAXED, __HIP_MEMORY_SCOPE_AGENT);
        }
    }
};
struct EpiFused {
    static constexpr bool PERM = true, AFTER_DRAIN = false;
    unsigned char* ws; const float* xc; const float* xl; float* out; int l; size_t o_merged, o_gates, o_mod; int probe;
    __device__ __forceinline__ void mid(f32x4 (&acc)[2][2][4][2], const Unit& u, int wr, int wc, int fr, int fq, int br) const {
        const int tidf = (wr * 4 + wc) * 64 + fq * 16 + fr; const bf16_t* gates = (const bf16_t*)(ws + o_gates);
#pragma unroll
        for (int ai = 0; ai < 2; ++ai)
            {
                u32x4 a[4][2], b[4][2];
#pragma unroll
                for (int m = 0; m < 4; ++m) { const bf16_t* gp = gates + ((((size_t)u.pm * 24 + (br * 8 + u.pn)) * 16 + (ai * 8 + m * 2)) * 512 + tidf) * 8;
#pragma unroll
                    for (int bj = 0; bj < 2; ++bj) { a[m][bj] = *(const u32x4*)(gp + bj * 4096); b[m][bj] = *(const u32x4*)(gp + bj * 4096 + (size_t)8 * 16 * 512 * 8); } }
                __builtin_amdgcn_sched_barrier(0);
#pragma unroll
                for (int m = 0; m < 4; ++m)
#pragma unroll
                    for (int bj = 0; bj < 2; ++bj) { const u32x4 x = a[m][bj], y = b[m][bj];
                        acc[ai][bj][m][0] = acc[ai][bj][m][0] * (f32x4){(1.f + e_lo(y.x)) * __builtin_amdgcn_rcpf(1.f + e_lo(x.x)), (1.f + e_hi(y.x)) * __builtin_amdgcn_rcpf(1.f + e_hi(x.x)), (1.f + e_lo(y.y)) * __builtin_amdgcn_rcpf(1.f + e_lo(x.y)), (1.f + e_hi(y.y)) * __builtin_amdgcn_rcpf(1.f + e_hi(x.y))};
                        acc[ai][bj][m][1] = acc[ai][bj][m][1] * (f32x4){(1.f + e_lo(y.z)) * __builtin_amdgcn_rcpf(1.f + e_lo(x.z)), (1.f + e_hi(y.z)) * __builtin_amdgcn_rcpf(1.f + e_hi(x.z)), (1.f + e_lo(y.w)) * __builtin_amdgcn_rcpf(1.f + e_lo(x.w)), (1.f + e_hi(y.w)) * __builtin_amdgcn_rcpf(1.f + e_hi(x.w))}; }
                __builtin_amdgcn_sched_barrier(0);
            }
    }
    __device__ __forceinline__ void operator()(const f32x4 (&acc)[2][2][4][2], const Unit& u, int wr, int wc, int fr, int fq) const {
        const int rowt = u.pm * BM; const int row0 = rowt + wr * 64 + fr; const int col0 = u.pn * BM + wc * 32 + 8 * fq;
        if (u.type == 0) { const bf16_t* gates = (const bf16_t*)(ws + o_gates); bf16_t* merged = (bf16_t*)(ws + o_merged);
#pragma unroll
            for (int ai = 0; ai < 2; ++ai) { u32x4 g[4][2];
#pragma unroll
                for (int m = 0; m < 4; ++m)
#pragma unroll
                    for (int bj = 0; bj < 2; ++bj) g[m][bj] = *(const u32x4*)(gates + ((((size_t)u.pm * 24 + (16 + u.pn)) * 16 + (ai * 8 + m * 2 + bj)) * 512 + ((wr * 4 + wc) * 64 + fq * 16 + fr)) * 8);
                __builtin_amdgcn_sched_barrier(0);
#pragma unroll
                for (int m = 0; m < 4; ++m) { const size_t row = (size_t)(row0 + ai * HALF + m * 16);
#pragma unroll
                    for (int bj = 0; bj < 2; ++bj) { const u32x4 gg = g[m][bj];
                        const f32x4 v0 = acc[ai][bj][m][0] * (f32x4){__builtin_amdgcn_rcpf(1.f + e_lo(gg.x)), __builtin_amdgcn_rcpf(1.f + e_hi(gg.x)), __builtin_amdgcn_rcpf(1.f + e_lo(gg.y)), __builtin_amdgcn_rcpf(1.f + e_hi(gg.y))}, v1 = acc[ai][bj][m][1] * (f32x4){__builtin_amdgcn_rcpf(1.f + e_lo(gg.z)), __builtin_amdgcn_rcpf(1.f + e_hi(gg.z)), __builtin_amdgcn_rcpf(1.f + e_lo(gg.w)), __builtin_amdgcn_rcpf(1.f + e_hi(gg.w))};
                        u32x4 w; w.x = cvt_pk_bf16(v0[0], v0[1]); w.y = cvt_pk_bf16(v0[2], v0[3]); w.z = cvt_pk_bf16(v1[0], v1[1]); w.w = cvt_pk_bf16(v1[2], v1[3]);
                        *(u32x4*)(merged + row * 2048 + col0 + bj * HALF) = w; } }
                __builtin_amdgcn_sched_barrier(0); }
        } else {
            const float* mod = (const float*)(ws + o_mod) + (size_t)l * 5 * 6144; const float* gate = mod + ((rowt < 4096) ? 0 : 1 + ((rowt - 4096) >> 11)) * 6144 + 4096;
            const float* xo = (rowt < 4096) ? xc : xl - (size_t)4096 * 2048;
            f32x4 gv[2][2];
#pragma unroll
            for (int bj = 0; bj < 2; ++bj)
#pragma unroll
                for (int n = 0; n < 2; ++n) gv[bj][n] = *(const f32x4*)(gate + col0 + bj * HALF + 4 * n);
            unsigned ob1 = (unsigned)(row0 * 2048 + col0) * 4u; asm volatile("" : "+v"(ob1));
#pragma unroll
            for (int ai = 0; ai < 2; ++ai)
#pragma unroll
              for (int mh = 0; mh < 2; ++mh) {
                f32x4 xv[2][2][2];
#pragma unroll
                for (int m2 = 0; m2 < 2; ++m2) { const unsigned ob = ob1 + (unsigned)(ai * HALF + (mh * 2 + m2) * 16) * 8192u;
#pragma unroll
                    for (int bj = 0; bj < 2; ++bj)
#pragma unroll
                        for (int n = 0; n < 2; ++n) xv[m2][bj][n] = *(const f32x4*)((const char*)xo + (size_t)(ob + (unsigned)(bj * HALF + 4 * n) * 4u)); }
                __builtin_amdgcn_sched_barrier(0);
#pragma unroll
                for (int m2 = 0; m2 < 2; ++m2) { const int m = mh * 2 + m2; const unsigned ob = ob1 + (unsigned)(ai * HALF + m * 16) * 8192u;
#pragma unroll
                    for (int bj = 0; bj < 2; ++bj)
#pragma unroll
                        for (int n = 0; n < 2; ++n) { if (!probe) *(f32x4*)((char*)out + (size_t)(ob + (unsigned)(bj * HALF + 4 * n) * 4u)) = xv[m2][bj][n] + gv[bj][n] * acc[ai][bj][m][n]; } }
                asm volatile("" ::: "memory"); }
        }
    }
};
}
namespace att {
using bf16 = __hip_bfloat16;
constexpr int   D = 128, NW = 8, QBLK = 32, KVBLK = 64;
constexpr float SCALE = 0.088388347648318440f;
constexpr float THR = 8.f;
constexpr int SDEPTH = 2;
constexpr int LDQ = 5120, LDK = 256, LDO = 2048;
constexpr size_t SHM_V = KVBLK * D * 2, SHM_K = KVBLK * D * 2, SHM_ATTN = 2 * SHM_V + 2 * SHM_K + NW * 64 * 4;
constexpr int STG_OFF = (int)SHM_ATTN, STG_WAVE = 32 * 272;
using bf16x8 = __attribute__((ext_vector_type(8))) short;
using s16x4  = __attribute__((ext_vector_type(4))) short;
using f32x16 = __attribute__((ext_vector_type(16))) float;
using f32x8  = __attribute__((ext_vector_type(8))) float;
using u32x4  = __attribute__((ext_vector_type(4))) unsigned;
#define KSWZ(row, colB) ((row) * 256 + ((colB) ^ (((row) & 7) << 4)))
#define SBAR() __builtin_amdgcn_sched_barrier(0)
__device__ __forceinline__ int crow(int r, int hi) { return (r & 3) + 8 * (r >> 2) + 4 * hi; }
__device__ __forceinline__ unsigned cvtpk(float lo, float hi) {
  unsigned r; asm volatile("v_cvt_pk_bf16_f32 %0, %1, %2" : "=v"(r) : "v"(lo), "v"(hi)); return r;
}
template <typename TIn> struct Stage;
template <> struct Stage<bf16>  { using T = bf16x8;
  __device__ static __forceinline__ T ld8(const bf16* p) { return *reinterpret_cast<const bf16x8*>(p); }
  __device__ static __forceinline__ bf16x8 tobf(T x) { return x; } };
template <> struct Stage<float> { using T = f32x8;
  __device__ static __forceinline__ T ld8(const float* p) { return *reinterpret_cast<const f32x8*>(p); }
  __device__ static __forceinline__ bf16x8 tobf(T x) {
    u32x4 w = {cvtpk(x[0], x[1]), cvtpk(x[2], x[3]), cvtpk(x[4], x[5]), cvtpk(x[6], x[7])}; return *reinterpret_cast<bf16x8*>(&w); } };

__device__ __forceinline__ void partialSM(f32x16& p0, f32x16& p1, float& m_reg, float& mn, float& alpha) {
  constexpr float C = SCALE * 1.4426950408889634f;
  float pmax = p0[0]; for (int r = 1; r < 16; ++r) pmax = fmaxf(pmax, p0[r]); for (int r = 0; r < 16; ++r) pmax = fmaxf(pmax, p1[r]);
  { auto rr = __builtin_amdgcn_permlane32_swap(__float_as_uint(pmax), __float_as_uint(pmax), false, false);
    pmax = fmaxf(__uint_as_float(rr[0]), __uint_as_float(rr[1])); }
  if (__builtin_expect(__all(pmax - m_reg <= THR / SCALE), 1)) { mn = m_reg; alpha = 1.f; }
  else { mn = fmaxf(m_reg, pmax); alpha = __builtin_amdgcn_exp2f((m_reg - mn) * C); m_reg = mn; }
  float mnC = -mn * C;
  for (int r = 0; r < 16; ++r) p0[r] = fmaf(p0[r], C, mnC); for (int r = 0; r < 16; ++r) p1[r] = fmaf(p1[r], C, mnC);
  for (int r = 0; r < 16; ++r) p0[r] = __builtin_amdgcn_exp2f(p0[r]);
}
__device__ __forceinline__ void finishSM(f32x16& p0, f32x16& p1, float alpha, float& l_reg, bf16x8& pa0, bf16x8& pa1, bf16x8& pa2, bf16x8& pa3) {
  for (int r = 0; r < 16; ++r) p1[r] = __builtin_amdgcn_exp2f(p1[r]);
  float ps = 0; for (int r = 0; r < 16; ++r) ps += p0[r]; for (int r = 0; r < 16; ++r) ps += p1[r];
  { auto rr = __builtin_amdgcn_permlane32_swap(__float_as_uint(ps), __float_as_uint(ps), false, false);
    ps = __uint_as_float(rr[0]) + __uint_as_float(rr[1]); }
  l_reg = l_reg * alpha + ps;
#define PK4(P, BASE, OUT) do { unsigned a0 = cvtpk(P[BASE + 0], P[BASE + 1]), a1 = cvtpk(P[BASE + 2], P[BASE + 3]);   \
    unsigned b0 = cvtpk(P[BASE + 4], P[BASE + 5]), b1 = cvtpk(P[BASE + 6], P[BASE + 7]);                              \
    auto r0 = __builtin_amdgcn_permlane32_swap(a0, b0, false, false); auto r1 = __builtin_amdgcn_permlane32_swap(a1, b1, false, false); \
    u32x4 w = {r0[0], r1[0], r0[1], r1[1]}; OUT = *reinterpret_cast<bf16x8*>(&w); } while (0)
  PK4(p0, 0, pa0); PK4(p0, 8, pa1); PK4(p1, 0, pa2); PK4(p1, 8, pa3);
#undef PK4
}
__device__ __forceinline__ void qkt(f32x16& p0, f32x16& p1, const bf16* Ks, const bf16x8* qr, int r32, int hi) {
  p0 = f32x16{}; p1 = f32x16{};
  for (int d0 = 0; d0 < 8; ++d0) { int cb = (d0 * 16 + hi * 8) * 2;
    bf16x8 b0 = *reinterpret_cast<const bf16x8*>((const char*)Ks + KSWZ(r32, cb));
    bf16x8 b1 = *reinterpret_cast<const bf16x8*>((const char*)Ks + KSWZ(32 + r32, cb));
    p0 = __builtin_amdgcn_mfma_f32_32x32x16_bf16(b0, qr[d0], p0, 0, 0, 0);
    p1 = __builtin_amdgcn_mfma_f32_32x32x16_bf16(b1, qr[d0], p1, 0, 0, 0); }
}
__device__ __forceinline__ int v_st(int k, int c) { const int kk = (k & ~0xC) | ((k & 4) << 1) | ((k & 8) >> 1); return ((kk >> 3) * 4 + (c >> 5)) * 512 + ((kk & 7) * 32 + (c & 31)) * 2; }
__device__ __forceinline__ int v_rd_base(int lane) { return ((lane & 3) << 3) | (((lane >> 2) & 3) << 6) | (((lane >> 4) & 1) << 5) | (((lane >> 5) & 1) << 8); }
constexpr int v_rd_off(int d0, int ks, int half) { return d0 * 512 + ks * 4096 + half * 2048; }
template <int OFF> __device__ __forceinline__ s16x4 tr_read(int vb) {
  s16x4 r; asm volatile("ds_read_b64_tr_b16 %0, %1 offset:%2" : "=&v"(r) : "v"(vb), "i"(OFF) : "memory"); return r;
}
template <int D0> __device__ __forceinline__ void pv_one(f32x16& od, int vb, bf16x8 pa0, bf16x8 pa1, bf16x8 pa2, bf16x8 pa3) {
  const s16x4 l0 = tr_read<v_rd_off(D0, 0, 0)>(vb), h0 = tr_read<v_rd_off(D0, 0, 1)>(vb), l1 = tr_read<v_rd_off(D0, 1, 0)>(vb), h1 = tr_read<v_rd_off(D0, 1, 1)>(vb);
  const s16x4 l2 = tr_read<v_rd_off(D0, 2, 0)>(vb), h2 = tr_read<v_rd_off(D0, 2, 1)>(vb), l3 = tr_read<v_rd_off(D0, 3, 0)>(vb), h3 = tr_read<v_rd_off(D0, 3, 1)>(vb);
  asm volatile("s_waitcnt lgkmcnt(0)" ::: "memory"); SBAR();
#define PK(L, H) (bf16x8){L[0], L[1], L[2], L[3], H[0], H[1], H[2], H[3]}
  od = __builtin_amdgcn_mfma_f32_32x32x16_bf16(pa0, PK(l0, h0), od, 0, 0, 0);
  od = __builtin_amdgcn_mfma_f32_32x32x16_bf16(pa1, PK(l1, h1), od, 0, 0, 0);
  od = __builtin_amdgcn_mfma_f32_32x32x16_bf16(pa2, PK(l2, h2), od, 0, 0, 0);
  od = __builtin_amdgcn_mfma_f32_32x32x16_bf16(pa3, PK(l3, h3), od, 0, 0, 0);
#undef PK
}
__device__ __forceinline__ void pv_d0(f32x16* o, int vb, bf16x8 pa0, bf16x8 pa1, bf16x8 pa2, bf16x8 pa3) {
  pv_one<0>(o[0], vb, pa0, pa1, pa2, pa3); pv_one<1>(o[1], vb, pa0, pa1, pa2, pa3); pv_one<2>(o[2], vb, pa0, pa1, pa2, pa3); pv_one<3>(o[3], vb, pa0, pa1, pa2, pa3);
}

template <typename TQ>
__device__ __forceinline__ void attn_dense_body(const TQ* Qb, const bf16* __restrict__ Kh, const bf16* __restrict__ Vh,
                                                const bf16* __restrict__ Gb, bf16* __restrict__ Ob, int seq, char* lds) {
  using St = Stage<bf16>; using SQ = Stage<TQ>;
  int tid_ = threadIdx.x; asm volatile("" : "+v"(tid_)); const int tid = tid_, wid = __builtin_amdgcn_readfirstlane(tid >> 6), lane = tid & 63, r32 = lane & 31, hi = lane >> 5;
  bf16* V_lds = (bf16*)lds; bf16* K_lds = (bf16*)(lds + 2 * SHM_V);
  float* ws = (float*)(lds + 2 * SHM_V + 2 * SHM_K) + wid * 64; float* li_l = ws; float* al_l = ws + 32;
  float m_reg = -1e30f, l_reg = 0; f32x16 o[4] = {}; bf16x8 qr[8];
  const TQ* Qw = Qb + (long)(wid * QBLK + r32) * LDQ + hi * 8;
#pragma unroll
  for (int d0 = 0; d0 < 8; ++d0) qr[d0] = SQ::tobf(SQ::ld8(Qw + d0 * 16));
  const int sr = tid >> 4, sc = (tid & 15) * 8, vst0 = v_st(sr, sc), vst1 = v_st(32 + sr, sc);
  const int vb0 = (int)(uintptr_t)V_lds + v_rd_base(lane);
  struct { typename St::T vs0, vs1, ks0, ks1; } sr_[SDEPTH];
#define SLOAD(i, k0) do { sr_[i].vs0 = St::ld8(&Vh[(long)((k0) + sr) * LDK + sc]); sr_[i].vs1 = St::ld8(&Vh[(long)((k0) + 32 + sr) * LDK + sc]); \
    sr_[i].ks0 = St::ld8(&Kh[(long)((k0) + sr) * LDK + sc]); sr_[i].ks1 = St::ld8(&Kh[(long)((k0) + 32 + sr) * LDK + sc]); } while (0)
#define SWRITE(b, i) do { *(bf16x8*)((char*)V_lds + (b) * SHM_V + vst0) = St::tobf(sr_[i].vs0);          \
    *(bf16x8*)((char*)V_lds + (b) * SHM_V + vst1) = St::tobf(sr_[i].vs1); int kc = sc * 2;               \
    *(bf16x8*)((char*)K_lds + (b) * SHM_K + KSWZ(sr, kc)) = St::tobf(sr_[i].ks0);                       \
    *(bf16x8*)((char*)K_lds + (b) * SHM_K + KSWZ(32 + sr, kc)) = St::tobf(sr_[i].ks1); } while (0)
#define SWAIT() do { if constexpr (SDEPTH == 2) asm volatile("s_waitcnt vmcnt(4)" ::: "memory"); else asm volatile("s_waitcnt vmcnt(0)" ::: "memory"); } while (0)
#define RESC(a) do { if (__any((a) < 1.f)) { if (hi == 0) al_l[r32] = (a); asm volatile("s_waitcnt lgkmcnt(0)" ::: "memory"); \
    for (int d = 0; d < 4; ++d) for (int r = 0; r < 16; ++r) o[d][r] *= al_l[crow(r, hi)]; } } while (0)
  f32x16 pA0, pA1, pB0, pB1; float mnA, mnB, alA, alB; bf16x8 pa0, pa1, pa2, pa3; const int NT = seq / KVBLK;
  constexpr int SE = 0, SO = SDEPTH - 1;
  SLOAD(SE, 0); asm volatile("s_waitcnt vmcnt(0)" ::: "memory"); SWRITE(0, SE); __syncthreads();
  qkt(pA0, pA1, K_lds, qr, r32, hi); partialSM(pA0, pA1, m_reg, mnA, alA);
  SLOAD(SO, KVBLK); if constexpr (SDEPTH == 2) { if (2 < NT) SLOAD(SE, 2 * KVBLK); }
  SWAIT(); SWRITE(1, SO); __syncthreads();
  for (int j = 1; j + 1 < NT; j += 2) {
    SBAR(); qkt(pB0, pB1, (bf16*)((char*)K_lds + SHM_K), qr, r32, hi);
    finishSM(pA0, pA1, alA, l_reg, pa0, pa1, pa2, pa3); SBAR();
    SLOAD(SO, (j + SDEPTH) * KVBLK); SBAR();
    pv_d0(o, vb0, pa0, pa1, pa2, pa3); partialSM(pB0, pB1, m_reg, mnB, alB);
    __syncthreads(); SWAIT(); SWRITE(0, SE);
    RESC(alB); __syncthreads();
    SBAR(); qkt(pA0, pA1, K_lds, qr, r32, hi);
    finishSM(pB0, pB1, alB, l_reg, pa0, pa1, pa2, pa3); SBAR();
    if (SDEPTH == 1 || j + 3 < NT) SLOAD(SE, (j + 1 + SDEPTH) * KVBLK); SBAR();
    pv_d0(o, vb0 + (int)SHM_V, pa0, pa1, pa2, pa3); partialSM(pA0, pA1, m_reg, mnA, alA);
    __syncthreads(); SWAIT(); SWRITE(1, SO);
    RESC(alA); __syncthreads();
  }
  SBAR(); qkt(pB0, pB1, (bf16*)((char*)K_lds + SHM_K), qr, r32, hi);
  finishSM(pA0, pA1, alA, l_reg, pa0, pa1, pa2, pa3); SBAR();
  pv_d0(o, vb0, pa0, pa1, pa2, pa3); partialSM(pB0, pB1, m_reg, mnB, alB);
  __syncthreads(); RESC(alB);
  finishSM(pB0, pB1, alB, l_reg, pa0, pa1, pa2, pa3); SBAR();
  pv_d0(o, vb0 + (int)SHM_V, pa0, pa1, pa2, pa3);
  if (hi == 0) li_l[r32] = l_reg; asm volatile("s_waitcnt lgkmcnt(0)" ::: "memory");
  float rli[16];
#pragma unroll
  for (int r = 0; r < 16; ++r) rli[r] = __builtin_amdgcn_rcpf(li_l[crow(r, hi)]);
  { char* stg = lds + STG_OFF + wid * STG_WAVE;
#pragma unroll
    for (int r = 0; r < 16; ++r) { const int orow = crow(r, hi);
#pragma unroll
      for (int d0 = 0; d0 < 4; ++d0) *(bf16*)(stg + orow * 272 + (d0 * 32 + r32) * 2) = __float2bfloat16(o[d0][r] * rli[r]); }
    asm volatile("s_waitcnt lgkmcnt(0)" ::: "memory");
    int lane2 = lane; asm volatile("" : "+v"(lane2), "+s"(Gb), "+s"(Ob));
#pragma unroll
    for (int i = 0; i < 8; ++i) { const int id = i * 64 + lane2, row = id >> 4, ch = id & 15;
      const u32x4 ov = *(const u32x4*)(stg + row * 272 + ch * 16);
      const u32x4 gv = *(const u32x4*)(Gb + (long)(wid * QBLK + row) * LDQ + ch * 8);
      u32x4 w;
#define SG(o_, g_) ((o_) * (g_) * __builtin_amdgcn_rcpf(1.f + __expf(-(g_))))
#define LO(x) __uint_as_float((x) << 16)
#define HI(x) __uint_as_float((x) & 0xffff0000u)
      w.x = cvtpk(SG(LO(ov.x), LO(gv.x)), SG(HI(ov.x), HI(gv.x))); w.y = cvtpk(SG(LO(ov.y), LO(gv.y)), SG(HI(ov.y), HI(gv.y)));
      w.z = cvtpk(SG(LO(ov.z), LO(gv.z)), SG(HI(ov.z), HI(gv.z))); w.w = cvtpk(SG(LO(ov.w), LO(gv.w)), SG(HI(ov.w), HI(gv.w)));
#undef SG
#undef LO
#undef HI
      *(u32x4*)(Ob + (long)(wid * QBLK + row) * LDO + ch * 8) = w; } }
  __syncthreads();
#undef SLOAD
#undef SWRITE
#undef SWAIT
#undef RESC
}
}
#undef SBAR
#undef KSWZ
#define LAS __attribute__((address_space(3)))
typedef unsigned short bf16_t;
typedef float f32x4 __attribute__((ext_vector_type(4)));
typedef unsigned u32x4 __attribute__((ext_vector_type(4)));
typedef unsigned u32x2 __attribute__((ext_vector_type(2)));
typedef short bf16x8 __attribute__((ext_vector_type(8)));

constexpr int DM = 2048, MC = 4096, ML = 8192, MT = 12288;
constexpr int INC = 5120, MGC = 6144, NCAT = INC + MGC, NCAT1 = NCAT - 2048;
constexpr int C_Q = 0, C_K = 1024, C_V = 1280, C_GA = 1536, C_U = 2560, C_VB = 3072, C_GB = 3584, C_Z = 4096, C_GC = 4608;
constexpr int KVLAT = 2304;
constexpr float EPS = 1e-6f;
constexpr size_t OFF_SK = (size_t)MT * DM, OFF_SV = OFF_SK + 16 * 2 * 256 * 256;
constexpr size_t MiB = 1u << 20;
constexpr size_t WS_ROPE = 64 * 1024, WS_MOD = 128 * 1024, WS_WPOOL = 512 * 1024;
constexpr size_t WS_WCAT = 1 * MiB, WS_WBRA = 45 * MiB, WS_WBRB = 49 * MiB, WS_WBRC = 51 * MiB, WS_WOUT = 53 * MiB;
constexpr size_t WS_MIX = 387 * MiB, WS_MERGED = 109 * MiB;
constexpr size_t WS_H = 61 * MiB, WS_PROJ = 109 * MiB, WS_GATES = 229 * MiB, WS_KB = 373 * MiB, WS_VB = 380 * MiB, WS_END = 435 * MiB;
constexpr int LDS_BYTES = 147456, LDS_CTL = 147200;
constexpr int NPH = 10;
constexpr int CW_TMO = 3500, CW_CNT = 4096;
constexpr size_t CTL_ZERO_BYTES = 65536;

__device__ __forceinline__ float bflo(unsigned u) { return __uint_as_float(u << 16); }
__device__ __forceinline__ float bfhi(unsigned u) { return __uint_as_float(u & 0xffff0000u); }
__device__ __forceinline__ unsigned f2bf(float f) { unsigned u = __float_as_uint(f); return (u + 0x7fffu + ((u >> 16) & 1u)) >> 16; }
__device__ __forceinline__ unsigned pk2(float lo, float hi) { return pg8::cvt_pk_bf16(lo, hi); }
__device__ __forceinline__ float silu_f(float g) { return g * __builtin_amdgcn_rcpf(1.f + __expf(-g)); }
__device__ __forceinline__ float wave_sum(float v) {
#pragma unroll
    for (int o = 1; o < 64; o <<= 1) v += __shfl_xor(v, o);
    return v;
}

struct Args { const float* in[24]; float* out; unsigned char* ws; int ph_lo, ph_hi; };

__host__ __device__ __forceinline__ int sig_inv(int d) { const int hi = (d >> 5) & 1, q = (d & 31) + ((d >> 6) << 5); return 8 * (q >> 2) + (q & 3) + 4 * hi; }
__device__ __forceinline__ void tr_item(const float* W, int K, int N, bf16_t* WT, int row_off, LAS float* scr, int item, int lane, int ldo = 0, int koff = 0, bool perm = false) {
    if (ldo == 0) ldo = K;
    const int nblk = N / 32, kb = item / nblk, nb = item % nblk, k0 = 64 * kb, n0 = 32 * nb;
#pragma unroll 8
    for (int i = 0; i < 32; ++i) { const int kk = 2 * i + (lane >> 5); scr[kk * 33 + (lane & 31)] = __builtin_nontemporal_load(W + (size_t)(k0 + kk) * N + n0 + (lane & 31)); }
    asm volatile("s_waitcnt lgkmcnt(0)" ::: "memory");
    const int c = lane & 7;
#pragma unroll
    for (int j = 0; j < 4; ++j) { const int n = (lane >> 3) + 8 * j; const LAS float* s = scr + (8 * c) * 33 + n;
        u32x4 o; o.x = pk2(s[0 * 33], s[1 * 33]); o.y = pk2(s[2 * 33], s[3 * 33]); o.z = pk2(s[4 * 33], s[5 * 33]); o.w = pk2(s[6 * 33], s[7 * 33]);
        int nr = row_off + n0 + n; if (perm && nr < 1280) nr = (nr & ~127) + sig_inv(nr & 127);
        *(u32x4*)(WT + (size_t)nr * ldo + koff + k0 + 8 * c) = o; }
    asm volatile("s_waitcnt lgkmcnt(0)" ::: "memory");
}
__device__ __forceinline__ void convert_weights(const Args& a, int l, LAS float* scr, int gw, int NGW, int lane, bool pool) {
    unsigned char* ws = a.ws;
    constexpr int I_IN = 32 * 160, I_MG = 32 * 192, I_A = 16 * 64, I_B = 8 * 64, I_O = 32 * 64;
    constexpr int NIT = I_IN + I_MG + I_A + 2 * I_B + I_O;
    const int nit = NIT + (pool ? 64 : 0);
    for (int it = gw; it < nit; it += NGW) {
        int r = it;
        if (r < I_IN) { tr_item(a.in[9] + (size_t)l * 2048 * 5120, 2048, 5120, (bf16_t*)(ws + WS_WCAT), 0, scr, r, lane, 0, 0, true); continue; } r -= I_IN;
        if (r < I_MG) { tr_item(a.in[20] + (size_t)l * 2048 * 6144, 2048, 6144, (bf16_t*)(ws + WS_WCAT), 5120, scr, r, lane); continue; } r -= I_MG;
        if (r < I_A) { tr_item(a.in[17] + (size_t)l * 1024 * 2048, 1024, 2048, (bf16_t*)(ws + WS_WBRA), 0, scr, r, lane, 2048, 0); continue; } r -= I_A;
        if (r < I_B) { tr_item(a.in[18] + (size_t)l * 512 * 2048, 512, 2048, (bf16_t*)(ws + WS_WBRA), 0, scr, r, lane, 2048, 1024); continue; } r -= I_B;
        if (r < I_B) { tr_item(a.in[19] + (size_t)l * 512 * 2048, 512, 2048, (bf16_t*)(ws + WS_WBRA), 0, scr, r, lane, 2048, 1536); continue; } r -= I_B;
        if (r < I_O) { tr_item(a.in[22] + (size_t)l * 2048 * 2048, 2048, 2048, (bf16_t*)(ws + WS_WOUT), 0, scr, r, lane); continue; } r -= I_O;
        { const int mat = r >> 3; tr_item(a.in[15] + (size_t)mat * 16384, 128, 128, (bf16_t*)(ws + WS_WPOOL) + (size_t)mat * 16384, 0, scr, r & 7, lane); }
    }
}

__device__ __forceinline__ void phase_prologue(const Args& a, unsigned char* lds, int tid, int lane, int wave, int bx, int G, int gw, int NGW) {
    float* mod = (float*)(a.ws + WS_MOD);
    for (int u = bx; u < 192; u += G) {
        const int l = u / 96, cb = u % 96;
        LAS float* sv = (LAS float*)lds; LAS float* red = sv + 5 * 2048;
        for (int i = tid; i < 5 * 2048; i += 512) { const int j = i >> 11, k = i & 2047; const float c = (j == 0) ? a.in[5][k] : a.in[4][(j - 1) * 2048 + k]; sv[i] = c / (1.f + __expf(-c)); }
        __syncthreads();
        const float* W = a.in[7] + (size_t)l * 2048 * 6144 + cb * 64 + lane;
        float a0 = 0.f, a1 = 0.f, a2 = 0.f, a3 = 0.f, a4 = 0.f;
        const int k0 = wave * 256;
#pragma unroll 32
        for (int k = k0; k < k0 + 256; ++k) { const float w = __builtin_nontemporal_load(W + (size_t)k * 6144); a0 += sv[k] * w; a1 += sv[2048 + k] * w; a2 += sv[4096 + k] * w; a3 += sv[6144 + k] * w; a4 += sv[8192 + k] * w; }
        red[(wave * 5 + 0) * 64 + lane] = a0; red[(wave * 5 + 1) * 64 + lane] = a1; red[(wave * 5 + 2) * 64 + lane] = a2; red[(wave * 5 + 3) * 64 + lane] = a3; red[(wave * 5 + 4) * 64 + lane] = a4;
        __syncthreads();
        if (tid < 320) { const int j = tid >> 6; float s = 0.f;
#pragma unroll
            for (int w = 0; w < 8; ++w) s += red[(w * 5 + j) * 64 + lane];
            const int col = cb * 64 + lane; mod[(size_t)(l * 5 + j) * 6144 + col] = s + a.in[8][l * 6144 + col]; }
        __syncthreads();
    }
    if (bx == G - 1 && wave == 7 && lane < 32) {
        double inv = 1.0; for (int i = 0; i < lane; ++i) inv *= 0.7498942093324559;
        const double x2 = inv * inv; double c = 1.0, s = inv, tc = 1.0, ts = inv;
        for (int n = 1; n <= 12; ++n) { tc *= -x2 / (double)((2 * n - 1) * (2 * n)); ts *= -x2 / (double)((2 * n) * (2 * n + 1)); c += tc; s += ts; }
        float* tab = (float*)(a.ws + WS_ROPE); double cr = 1.0, sr = 0.0;
        for (int p = 0; p < 64; ++p) { tab[(p * 32 + lane) * 2] = (float)cr; tab[(p * 32 + lane) * 2 + 1] = (float)sr; const double ncr = cr * c - sr * s; sr = sr * c + cr * s; cr = ncr; }
    }
    convert_weights(a, 0, (LAS float*)((LAS unsigned char*)lds + wave * 16384), gw, NGW, lane, true);
}

__device__ __forceinline__ void phase_norm(const Args& a, int l, int gw, int NGW, int lane) {
    const float* xc = l == 0 ? a.in[0] : a.out; const float* xl = l == 0 ? a.in[1] : a.out + (size_t)MC * DM;
    const float* nw = a.in[6] + l * DM; const float* mod = (const float*)(a.ws + WS_MOD) + (size_t)l * 5 * 6144;
    bf16_t* H = (bf16_t*)(a.ws + WS_H);
    for (int m = gw; m < MT; m += NGW) {
        const float* xr = (m < MC) ? xc + (size_t)m * DM : xl + (size_t)(m - MC) * DM;
        const float* md = mod + ((m < MC) ? 0 : 1 + ((m - MC) >> 11)) * 6144;
        f32x4 v[8]; float s = 0.f;
#pragma unroll
        for (int j = 0; j < 8; ++j) { v[j] = ((const f32x4*)xr)[lane + 64 * j]; s += (v[j].x * v[j].x + v[j].y * v[j].y) + (v[j].z * v[j].z + v[j].w * v[j].w); }
        const float rstd = 1.f / sqrtf(wave_sum(s) * (1.f / DM) + EPS);
#pragma unroll
        for (int j = 0; j < 8; ++j) { const int col = 4 * (lane + 64 * j);
            const f32x4 w = *(const f32x4*)(nw + col), sh = *(const f32x4*)(md + col), sc = *(const f32x4*)(md + 2048 + col);
            const f32x4 y = v[j] * rstd * w * (sc + 1.f) + sh; u32x2 o; o.x = pk2(y.x, y.y); o.y = pk2(y.z, y.w);
            *(u32x2*)(H + (size_t)m * DM + col) = o; }
    }
}
__device__ __forceinline__ void cache_rows(const Args& a, int l, int gw, int NGW, int lane) {
    bf16_t* KB = (bf16_t*)(a.ws + WS_KB); bf16_t* VB = (bf16_t*)(a.ws + WS_VB);
    for (int i = gw; i < 1024; i += NGW) { const int b = i >> 8, jj = i & 255; const size_t src = ((size_t)(b * 2 + l) * 256 + jj) * 256, dst = ((size_t)MC + (size_t)b * KVLAT + 2048 + jj) * 256 + 4 * lane;
        const int p4 = (4 * lane) & 127, kh = (4 * lane) >> 7, q = 4 * (p4 >> 3) + 0, bs = (q < 32 ? q : q + 32) + ((p4 & 4) ? 32 : 0);
        const f32x4 k = *(const f32x4*)(a.in[2] + src + kh * 128 + bs), v = *(const f32x4*)(a.in[3] + src + 4 * lane);
        u32x2 ko, vo; ko.x = pk2(k.x, k.y); ko.y = pk2(k.z, k.w); vo.x = pk2(v.x, v.y); vo.y = pk2(v.z, v.w);
        *(u32x2*)(KB + dst) = ko; *(u32x2*)(VB + dst) = vo; }
}
__device__ __forceinline__ void phase_final(const Args& a, int gw, int NGW, int lane) {
    const float* nw = a.in[23];
    for (int m = gw; m < MT; m += NGW) {
        float* xr = a.out + (size_t)m * DM; f32x4 v[8]; float s = 0.f;
#pragma unroll
        for (int j = 0; j < 8; ++j) { v[j] = ((const f32x4*)xr)[lane + 64 * j]; s += (v[j].x * v[j].x + v[j].y * v[j].y) + (v[j].z * v[j].z + v[j].w * v[j].w); }
        const float rstd = 1.f / sqrtf(wave_sum(s) * (1.f / DM) + EPS);
#pragma unroll
        for (int j = 0; j < 8; ++j) { const int col = 4 * (lane + 64 * j); __builtin_nontemporal_store(v[j] * rstd * *(const f32x4*)(nw + col), (f32x4*)xr + lane + 64 * j); }
    }
}

__device__ __forceinline__ void unpack8(const u32x4 v, float* x) { x[0] = bflo(v.x); x[1] = bfhi(v.x); x[2] = bflo(v.y); x[3] = bfhi(v.y); x[4] = bflo(v.z); x[5] = bfhi(v.z); x[6] = bflo(v.w); x[7] = bfhi(v.w); }
__device__ __forceinline__ u32x4 pack8(const float* x) { u32x4 o; o.x = pk2(x[0], x[1]); o.y = pk2(x[2], x[3]); o.z = pk2(x[4], x[5]); o.w = pk2(x[6], x[7]); return o; }
__device__ __forceinline__ void mm128(const LAS unsigned char* X, const LAS unsigned char* Y, int wave, int fr, int fq, f32x4 (&acc)[8]) {
    bf16x8 yb[4];
#pragma unroll
    for (int k = 0; k < 4; ++k) yb[k] = *(const LAS bf16x8*)(Y + (16 * wave + fr) * 272 + (k * 32 + fq * 8) * 2);
#pragma unroll
    for (int cb = 0; cb < 8; ++cb) { acc[cb] = (f32x4){0.f, 0.f, 0.f, 0.f};
#pragma unroll
        for (int k = 0; k < 4; ++k) { const bf16x8 xa = *(const LAS bf16x8*)(X + (16 * cb + fr) * 272 + (k * 32 + fq * 8) * 2);
            acc[cb] = __builtin_amdgcn_mfma_f32_16x16x32_bf16(xa, yb[k], acc[cb], 0, 0, 0); } }
}
constexpr int P3_X = 0, P3_Y = 34816, P3_Z = 69632;
__device__ __forceinline__ void sgu_unit(const Args& a, int l, int n, int g0, int g1, LAS unsigned char* lds, int tid, int lane, int wave) {
    bf16_t* PROJ = (bf16_t*)(a.ws + WS_PROJ); bf16_t* MIX = (bf16_t*)(a.ws + WS_MIX);
    asm volatile("" : "+v"(tid), "+v"(lane));
    const int q = tid >> 2, part = tid & 3, fr = lane & 15, fq = lane >> 4;
    const size_t rowoff = (size_t)(128 * n + q) * INC;
    u32x4 rv[16], xr[2][4]; f32x4 yr[2][8];
    { const bf16_t* p = PROJ + rowoff + C_VB + part * 128;
#pragma unroll
      for (int i = 0; i < 16; ++i) rv[i] = *(const u32x4*)(p + 8 * i); }
#pragma unroll
    for (int gi = 0; gi < 2; ++gi) { const int g = g0 + gi; const bf16_t* p = PROJ + rowoff + C_VB + g * 128 + part * 32; const float* W = a.in[13] + ((size_t)(l * 4 + g) * 128 + q) * 128 + part * 32;
#pragma unroll
        for (int i = 0; i < 4; ++i) xr[gi][i] = *(const u32x4*)(p + 8 * i);
#pragma unroll
        for (int i = 0; i < 8; ++i) yr[gi][i] = *(const f32x4*)(W + 4 * i); }
    float ss = 0.f;
#pragma unroll
    for (int i = 0; i < 16; ++i) { float f[8]; unpack8(rv[i], f);
#pragma unroll
        for (int e = 0; e < 8; ++e) ss += f[e] * f[e]; }
    ss += __shfl_xor(ss, 1); ss += __shfl_xor(ss, 2);
    const float rs = 1.f / sqrtf(ss * (1.f / 512.f) + EPS);
#pragma unroll
    for (int gi = 0; gi < 2; ++gi) { const int g = g0 + gi; LAS unsigned char* X = lds + gi * 69632 + P3_X; LAS unsigned char* Y = lds + gi * 69632 + P3_Y;
        const float* nw = a.in[12] + l * 512 + g * 128 + part * 32;
#pragma unroll
        for (int i = 0; i < 4; ++i) { float f[8]; unpack8(xr[gi][i], f); const f32x4 n0 = *(const f32x4*)(nw + 8 * i), n1 = *(const f32x4*)(nw + 8 * i + 4);
#pragma unroll
            for (int e = 0; e < 8; ++e) *(LAS bf16_t*)(X + (part * 32 + 8 * i + e) * 272 + q * 2) = (bf16_t)f2bf(f[e] * rs * (e < 4 ? n0[e] : n1[e - 4])); }
#pragma unroll
        for (int i = 0; i < 4; ++i) { const f32x4 w0 = yr[gi][2 * i], w1 = yr[gi][2 * i + 1];
            u32x4 o; o.x = pk2(w0.x, w0.y); o.y = pk2(w0.z, w0.w); o.z = pk2(w1.x, w1.y); o.w = pk2(w1.z, w1.w);
            *(LAS u32x4*)(Y + q * 272 + (part * 32 + 8 * i) * 2) = o; } }
    __syncthreads();
    const int p = 16 * wave + fr; const size_t ro = (size_t)(128 * n + p) * INC;
#pragma unroll
    for (int gi = 0; gi < 2; ++gi) { const int g = g0 + gi;
        u32x2 uu[8], gg[8];
#pragma unroll
        for (int cb = 0; cb < 8; ++cb) { const int c = g * 128 + 16 * cb + 4 * fq; uu[cb] = *(const u32x2*)(PROJ + ro + C_U + c); gg[cb] = *(const u32x2*)(PROJ + ro + C_GB + c); }
        const float bs = a.in[14][(l * 4 + g) * 128 + p];
        f32x4 acc[8]; mm128(lds + gi * 69632 + P3_X, lds + gi * 69632 + P3_Y, wave, fr, fq, acc);
#pragma unroll
        for (int cb = 0; cb < 8; ++cb) { const int c = g * 128 + 16 * cb + 4 * fq;
            const float v0 = bflo(uu[cb].x) * (acc[cb].x + bs) * silu_f(bflo(gg[cb].x)), v1 = bfhi(uu[cb].x) * (acc[cb].y + bs) * silu_f(bfhi(gg[cb].x));
            const float v2 = bflo(uu[cb].y) * (acc[cb].z + bs) * silu_f(bflo(gg[cb].y)), v3 = bfhi(uu[cb].y) * (acc[cb].w + bs) * silu_f(bfhi(gg[cb].y));
            u32x2 o; o.x = pk2(v0, v1); o.y = pk2(v2, v3); *(u32x2*)(MIX + (size_t)(128 * n + p) * DM + 1024 + c) = o; } }
    __syncthreads();
}
__device__ __forceinline__ void pool_unit(const Args& a, int l, int n, int g0, int g1, LAS unsigned char* lds, int tid, int lane, int wave) {
    bf16_t* PROJ = (bf16_t*)(a.ws + WS_PROJ); bf16_t* MIX = (bf16_t*)(a.ws + WS_MIX);
    LAS unsigned char* X = lds + P3_X; LAS unsigned char* Y = lds + P3_Y; LAS float* Z = (LAS float*)(lds + P3_Z);
    const int row0 = 128 * n; const bool lat = row0 >= MC; const int seqlen = lat ? 2048 : 256; const int t0 = lat ? ((row0 - MC) & 2047) : (row0 & 255);
    asm volatile("" : "+v"(tid), "+v"(lane));
    const int fr = lane & 15, fq = lane >> 4;
    u32x4 zr[5], xw[4];
#define POOL_PREFETCH(gi_) do { _Pragma("unroll") for (int i = 0; i < 5; ++i) { const int ch = tid + 512 * i; const int r = ch >> 4, c8 = (ch & 15) * 8, pos = t0 - 8 + r; \
            zr[i] = (u32x4){0u, 0u, 0u, 0u}; if (ch < 144 * 16 && pos >= 0 && pos < seqlen) zr[i] = *(const u32x4*)(PROJ + (size_t)(row0 - 8 + r) * INC + C_Z + (gi_) * 128 + c8); } \
        { const bf16_t* WP = (const bf16_t*)(a.ws + WS_WPOOL) + (size_t)(l * 4 + (gi_)) * 16384 + (tid >> 2) * 128 + (tid & 3) * 32; \
          _Pragma("unroll") for (int i = 0; i < 4; ++i) xw[i] = *(const u32x4*)(WP + 8 * i); } } while (0)
    POOL_PREFETCH(g0);
    for (int gi = g0; gi < g1; ++gi) {
        const int w = 2 << gi, hw = w >> 1;
#pragma unroll
        for (int i = 0; i < 5; ++i) { const int ch = tid + 512 * i; if (ch < 144 * 16) { const int r = ch >> 4, c8 = (ch & 15) * 8; float f[8]; unpack8(zr[i], f);
            *(LAS f32x4*)(Z + r * 128 + c8) = (f32x4){f[0], f[1], f[2], f[3]}; *(LAS f32x4*)(Z + r * 128 + c8 + 4) = (f32x4){f[4], f[5], f[6], f[7]}; } }
#pragma unroll
        for (int i = 0; i < 4; ++i) *(LAS u32x4*)(X + (tid >> 2) * 272 + ((tid & 3) * 32 + 8 * i) * 2) = xw[i];
        if (gi + 1 < g1) POOL_PREFETCH(gi + 1);
        const int tl = 16 * wave + fr; const size_t ro = (size_t)(row0 + tl) * INC;
        u32x2 gg[8]; f32x4 ps[8];
#pragma unroll
        for (int cb = 0; cb < 8; ++cb) { const int dch = gi * 128 + 16 * cb + 4 * fq; ps[cb] = *(const f32x4*)(a.in[16] + l * 512 + dch); gg[cb] = *(const u32x2*)(PROJ + ro + C_GC + dch); }
        __syncthreads();
        { const int c = tid & 127, t = 32 * (tid >> 7); float s = 0.f;
          for (int k = 0; k < w; ++k) s += Z[(t + 8 - hw + k) * 128 + c];
          for (int tt = 0; tt < 32; ++tt) { const int tl2 = t + tt, pos = t0 + tl2; const int lo = max(pos - hw, 0), hi = min(pos + w - hw, seqlen);
              const float dv = s / (float)(hi - lo) - Z[(tl2 + 8) * 128 + c];
              *(LAS bf16_t*)(Y + tl2 * 272 + c * 2) = (bf16_t)f2bf(dv);
              s += Z[(tl2 + 8 - hw + w) * 128 + c] - Z[(tl2 + 8 - hw) * 128 + c]; } }
        __syncthreads();
        f32x4 acc[8]; mm128(X, Y, wave, fr, fq, acc);
#pragma unroll
        for (int cb = 0; cb < 8; ++cb) { const int dch = gi * 128 + 16 * cb + 4 * fq;
            u32x2 o; o.x = pk2(acc[cb].x * ps[cb].x * silu_f(bflo(gg[cb].x)), acc[cb].y * ps[cb].y * silu_f(bfhi(gg[cb].x))); o.y = pk2(acc[cb].z * ps[cb].z * silu_f(bflo(gg[cb].y)), acc[cb].w * ps[cb].w * silu_f(bfhi(gg[cb].y)));
            *(u32x2*)(MIX + (size_t)(row0 + tl) * DM + 1536 + dch) = o; }
        __syncthreads();
    }
#undef POOL_PREFETCH
}
#define RLX_AGENT __ATOMIC_RELAXED, __HIP_MEMORY_SCOPE_AGENT
#define XB_TMO      128
#define XB_XCNT(j)  (256  + 64 * (j))
#define XB_XSUB(j)  (1280 + 64 * (j))
#define XB_XGEN(j)  (2304 + 64 * (j))
#define XB_TOP      3328
#define XB_TOPGEN   3392
#define XCD_BAR_WORDS 3456
#define XB_SPIN_CAP (1u << 18)

__device__ __forceinline__ unsigned xb_ld(unsigned* p)              { return __hip_atomic_load(p, __ATOMIC_RELAXED, __HIP_MEMORY_SCOPE_AGENT); }
__device__ __forceinline__ unsigned xb_add(unsigned* p, unsigned v) { return __hip_atomic_fetch_add(p, v, __ATOMIC_RELAXED, __HIP_MEMORY_SCOPE_AGENT); }
__device__ __forceinline__ unsigned xb_xcc_id() { return (unsigned)__builtin_amdgcn_s_getreg((3 << 11) | 20) & 0xFu; }
#define XB_SPIN(cond, bar) do { unsigned _sp = 0; while (cond) { __builtin_amdgcn_s_sleep(1); \
    if ((++_sp & 255u) == 0u) { if (xb_ld(&(bar)[XB_TMO])) break; if (_sp > XB_SPIN_CAP) { atomicAdd(&(bar)[XB_TMO], 1u); break; } } } } while (0)

struct XcdBarrier {
    unsigned* bar; unsigned x;
    volatile LAS unsigned* st;
};

__device__ __forceinline__ XcdBarrier xcd_barrier_post(unsigned* bar, volatile LAS unsigned* st) {
    XcdBarrier b; b.bar = bar; b.x = xb_xcc_id(); b.st = st;
    if (threadIdx.x == 0) (void)xb_add(&bar[XB_XCNT(b.x)], 1u);
    return b;
}
__device__ __forceinline__ void xcd_barrier_complete(unsigned* bar, unsigned x, unsigned& nloc, unsigned& nx) {
    const unsigned G = gridDim.x * gridDim.y * gridDim.z;
    unsigned sum, cnt, mine, sp = 0u;
    for (;;) {
        sum = 0u; cnt = 0u; mine = 0u;
#pragma unroll
        for (unsigned j = 0; j < 16; ++j) { const unsigned c = xb_ld(&bar[XB_XCNT(j)]); sum += c; cnt += (c > 0u) ? 1u : 0u; mine = (j == x) ? c : mine; }
        if (sum == G) break;
        __builtin_amdgcn_s_sleep(1);
        if ((++sp & 255u) == 0u) { if (xb_ld(&bar[XB_TMO])) break; if (sp > XB_SPIN_CAP) { atomicAdd(&bar[XB_TMO], 1u); break; } }
    }
    nloc = mine > 0u ? mine : 1u; nx = cnt > 0u ? cnt : 1u;
}

__device__ __forceinline__ void xcd_barrier(const XcdBarrier& b) {
    asm volatile("s_waitcnt vmcnt(0)" ::: "memory");
    __syncthreads();
    if (threadIdx.x == 0) {
        unsigned* bar = b.bar;
        __builtin_amdgcn_s_waitcnt(0);
        unsigned nloc = b.st[0], nx = b.st[1];
        if (nloc == 0u) { xcd_barrier_complete(bar, b.x, nloc, nx); b.st[0] = nloc; b.st[1] = nx; }
        const unsigned old = xb_add(&bar[XB_XSUB(b.x)], 1u);
        const unsigned gen = old / nloc;
        if (old + 1u == (gen + 1u) * nloc) {
            __builtin_amdgcn_fence(__ATOMIC_RELEASE, "agent");
            asm volatile("s_waitcnt vmcnt(0)" ::: "memory");
            const unsigned og = xb_add(&bar[XB_TOP], 1u);
            const unsigned tg = og / nx;
            if (og + 1u == (tg + 1u) * nx) xb_add(&bar[XB_TOPGEN], 1u);
            else XB_SPIN(xb_ld(&bar[XB_TOPGEN]) == tg, bar);
            __builtin_amdgcn_fence(__ATOMIC_ACQUIRE, "agent");
            xb_add(&bar[XB_XGEN(b.x)], 1u);
            asm volatile("s_waitcnt vmcnt(0)" ::: "memory");
        } else {
            XB_SPIN(xb_ld(&bar[XB_XGEN(b.x)]) == gen, bar);
            __builtin_amdgcn_fence(__ATOMIC_ACQUIRE, "agent");
            asm volatile("s_waitcnt vmcnt(0)" ::: "memory");
        }
    }
    __syncthreads();
}
#if defined(__HIP_DEVICE_COMPILE__)
#define LOAD_ARGS asm volatile("" : "+s"(ap)); const Args a = *ap; unsigned char* ws = a.ws; (void)ws
#else
#define LOAD_ARGS const Args a = a_unused; unsigned char* ws = a.ws; (void)ws
#endif
#ifndef PH_EN
#define PH_EN 0xff
#endif
#ifndef PROBE_PH
#define PROBE_PH 0
#endif
#ifndef PROBE_N
#define PROBE_N 0
#endif
#ifndef PROBE_MASK
#define PROBE_MASK 15
#endif
__global__ void __launch_bounds__(512, 2) mk_fwd(Args a_unused) {
    extern __shared__ __attribute__((aligned(16))) unsigned char lds[];
    if (threadIdx.x < 16) ((LAS unsigned*)((LAS unsigned char*)lds + LDS_CTL))[threadIdx.x] = 0u;
    __syncthreads();
    XcdBarrier bar = xcd_barrier_post((unsigned*)a_unused.ws + 0, (volatile LAS unsigned*)((LAS unsigned char*)lds + LDS_CTL));
    LAS unsigned char* L = (LAS unsigned char*)lds;
    typedef const __attribute__((address_space(4))) Args CArgs;
    CArgs* ap = (CArgs*)__builtin_amdgcn_kernarg_segment_ptr();
    (void)bar;
    for (int ph = 0; ; ++ph) {
        asm volatile("" : "+s"(ap));
        if (ph >= ap->ph_hi) break;
        if (ph > 0) { XcdBarrier b2; b2.bar = (unsigned*)ap->ws; b2.x = xb_xcc_id(); b2.st = (volatile LAS unsigned*)((LAS unsigned char*)lds + LDS_CTL); xcd_barrier(b2); }
        asm volatile("" : "+s"(ap));
        int tid = threadIdx.x, G = gridDim.x, bx = blockIdx.x;
        asm volatile("" : "+v"(tid), "+s"(G), "+s"(bx));
        const int lane = tid & 63, wave = __builtin_amdgcn_readfirstlane(tid >> 6);
        const int vcu = (G % 8 == 0) ? (bx % 8) * (G / 8) + bx / 8 : bx;
        const int gw = vcu * 8 + wave, NGW = G * 8;
        const bool probe = (PROBE_N > 0) && ph >= NPH; const int eph = probe ? PROBE_PH : ph;
        if (eph == 0) { LOAD_ARGS; if (PH_EN & 1) phase_prologue(a, lds, tid, lane, wave, bx, G, gw, NGW); continue; }
        if (eph == NPH - 1) { LOAD_ARGS; if (PH_EN & 128) phase_final(a, gw, NGW, lane); continue; }
        const int l = (eph - 1) / 4, s = (eph - 1) % 4;
        if (s == 0 && (PH_EN & 2)) { LOAD_ARGS;
            phase_norm(a, l, gw, NGW, lane);
            cache_rows(a, l, gw, NGW, lane);
            if (l == 1) convert_weights(a, 1, (LAS float*)(L + wave * 16384), gw, NGW, lane, false);
        } else if (s == 1 && (PH_EN & 4)) { LOAD_ARGS;
            pg8::Gemm g{(const bf16_t*)(ws + WS_H), (const bf16_t*)(ws + WS_WCAT), MT, NCAT1, DM, DM}; pg8::Gemm1Order S; S.init(MT, NCAT1, G, bx);
            pg8::EpiProj E{(bf16_t*)(ws + WS_PROJ), (bf16_t*)(ws + WS_GATES), a.in[21] + l * MGC, (probe && (PROBE_MASK & 16)) ? 1 : 0, 0, ws, a.out, a.in[10] + l * 128, a.in[11] + l * 128, l, (PG8_LAS float*)(L + 131072)};
            pg8::gemm_phase<pg8::EpiProj, pg8::Gemm1Order, true, true>(L, g, S, E);
        } else if (s == 2 && (PH_EN & 16)) { LOAD_ARGS;
            const att::bf16* PROJ = (const att::bf16*)(ws + WS_PROJ); const att::bf16* KB = (const att::bf16*)(ws + WS_KB); const att::bf16* VB = (const att::bf16*)(ws + WS_VB);
            att::bf16* MIX = (att::bf16*)(ws + WS_MIX);
            if (!probe || (PROBE_MASK & 32)) {
                pg8::Gemm g{(const bf16_t*)(ws + WS_H), (const bf16_t*)(ws + WS_WCAT) + (size_t)NCAT1 * DM, MT, 2048, DM, DM}; pg8::DeferOrder S{G, bx};
                pg8::EpiProj E{(bf16_t*)(ws + WS_PROJ), (bf16_t*)(ws + WS_GATES), a.in[21] + l * MGC, 0, 36, ws, a.out, a.in[10] + l * 128, a.in[11] + l * 128, l, (PG8_LAS float*)(L + 131072)};
                pg8::gemm_phase<pg8::EpiProj, pg8::DeferOrder, true, true>(L, g, S, E);
            }
            for (int k = 0; ; ++k) {
                int u;
                if (G == 256) { const int cc = bx - 64; if (k > (bx < 64 ? 0 : (cc < 128 ? 3 : 2))) break; u = (k == 0) ? vcu : 256 + (k - 1) * 192 + cc; }
                else { u = vcu + k * G; if (u >= 768) break; }
                const int sm = u - 256;
                if (probe) { const int kind = u < 256 ? 1 : (sm < 192 ? 2 : (sm < 384 ? 4 : 8)); if (!(PROBE_MASK & kind)) continue; }
                if (u >= 256 && sm < 384) {
#if defined(__HIP_DEVICE_COMPILE__)
                    asm volatile("" : "+s"(ap)); const Args a2 = *ap;
#else
                    const Args a2 = a_unused;
#endif
                    if (sm < 192) sgu_unit(a2, l, sm >> 1, (sm & 1) * 2, (sm & 1) * 2 + 2, L, tid, lane, wave);
                    else { const int pu = sm - 192; pool_unit(a2, l, pu >> 1, (pu & 1) * 2, (pu & 1) * 2 + 2, L, tid, lane, wave); }
                    continue; }
                int qrow0, kvrow0, h, seq;
                if (u < 256) { const int b = u >> 6, qb = u & 7; h = (u >> 3) & 7; qrow0 = MC + b * 2048 + qb * 256; kvrow0 = MC + b * KVLAT; seq = KVLAT; }
                else { const int uu = sm - 384, b = uu >> 3; h = uu & 7; qrow0 = b * 256; kvrow0 = b * 256; seq = 256; }
                const att::bf16* Q = PROJ + (size_t)qrow0 * INC + h * 128; const size_t ko = (size_t)kvrow0 * 256 + (h >> 2) * 128;
                att::attn_dense_body<att::bf16>(Q, KB + ko, VB + ko, Q + C_GA, MIX + (size_t)qrow0 * DM + h * 128, seq, (char*)lds);
            }
        } else if (s == 3 && (PH_EN & 32)) { LOAD_ARGS;
            pg8::Gemm2 g{(const bf16_t*)(ws + WS_MIX), (const bf16_t*)(ws + WS_WBRA), (const bf16_t*)(ws + WS_MERGED), (const bf16_t*)(ws + WS_WOUT), MT, DM, DM, DM};
            pg8::FusedOrder S{G, bx, (unsigned*)ws + CW_CNT + l * 4096};
            pg8::EpiFused E{ws, l == 0 ? a.in[0] : a.out, l == 0 ? a.in[1] : a.out + (size_t)MC * DM, a.out, l, WS_MERGED, WS_GATES, WS_MOD, probe ? 1 : 0};
            pg8::gemm_fused<pg8::EpiFused, pg8::FusedOrder, true, true>(L, g, S, E);
        }
    }
}

extern "C" void kernel_launch(void* const* d_in, const int* in_sizes, int n_in, void* d_out, int out_size, void* d_ws, size_t ws_size, hipStream_t stream) {
    static int grid = 0;
    if (grid == 0) {
        if (n_in != 24 || ws_size < WS_END) { fprintf(stderr, "kernel_launch: expected 24 inputs and >= %zu bytes of workspace; got %d, %zu\n", (size_t)WS_END, n_in, ws_size); grid = -1; return; }
        int dev = 0, cus = 0, per_cu = 0;
        if (hipGetDevice(&dev) != hipSuccess || hipDeviceGetAttribute(&cus, hipDeviceAttributeMultiprocessorCount, dev) != hipSuccess) { grid = -1; return; }
        if (hipFuncSetAttribute((const void*)mk_fwd, hipFuncAttributeMaxDynamicSharedMemorySize, LDS_BYTES) != hipSuccess) { fprintf(stderr, "kernel_launch: hipFuncSetAttribute failed\n"); grid = -1; return; }
        if (hipOccupancyMaxActiveBlocksPerMultiprocessor(&per_cu, (const void*)mk_fwd, 512, LDS_BYTES) != hipSuccess || per_cu < 1) { fprintf(stderr, "kernel_launch: occupancy query says %d\n", per_cu); per_cu = 1; }
        (void)hipGetLastError();
        grid = cus;
        fprintf(stderr, "kernel_launch: cus %d per_cu %d grid %d ws %zu\n", cus, per_cu, grid, ws_size);
    }
    if (grid < 0) return;
    Args a{};
    for (int i = 0; i < 24; ++i) a.in[i] = (const float*)d_in[i];
    a.out = (float*)d_out; a.ws = (unsigned char*)d_ws;
    a.ph_lo = 0; a.ph_hi = NPH + PROBE_N;
    if (hipMemsetAsync(d_ws, 0, CTL_ZERO_BYTES, stream) != hipSuccess) { fprintf(stderr, "kernel_launch: memset failed\n"); return; }
    hipLaunchKernelGGL(mk_fwd, dim3(grid), dim3(512), LDS_BYTES, stream, a);
}
```

```cpp
#include <hip/hip_runtime.h>
#include <hip/hip_bf16.h>
#include <cstdio>
#include <cstdint>
namespace pg8 {
#define PG8_LAS __attribute__((address_space(3)))
typedef unsigned short bf16_t;
typedef short bf16x8 __attribute__((ext_vector_type(8)));
typedef float f32x4 __attribute__((ext_vector_type(4)));
typedef unsigned u32x4 __attribute__((ext_vector_type(4)));
constexpr int BM = 256, BK = 64, HALF = 128, HTB = HALF * BK * 2  , STAGE_BYTES = 8 * HTB, NXCD = 8, WGM = 8;

__host__ __device__ __forceinline__ int lds_byte(int r, int c) { const int st = (r >> 4) * 2 + (c >> 5), rr = r & 15, cc = c & 31, ob = rr * 64 + cc * 2; return st * 1024 + (ob ^ (((ob >> 9) & 1) << 5)); }
__host__ __device__ __forceinline__ void stage_rc(int b, int& R, int& C) { const int st = b / 1024, sb = b % 1024, swz = sb ^ (((sb >> 9) & 1) << 5); R = (st >> 1) * 16 + swz / 64; C = (st & 1) * 32 + (swz % 64) / 2; }
__host__ __device__ __forceinline__ int perm32(int rho) { const int n = rho >> 4, i = rho & 15; return 8 * (i >> 2) + 4 * n + (i & 3); }

struct Unit { int pm, pn, type; };
struct Gemm { const bf16_t* A; const bf16_t* Bt; int M, N, K, lda; };

struct StaticOrder {
    int nM, nN, nwg, G, c;
    __host__ __device__ void init(int M, int N, int G_, int c_) { nM = M / BM; nN = N / BM; nwg = nM * nN; G = G_; c = c_; }
    __host__ __device__ bool next(int i, Unit& u) const {
        const long L = (long)i * G + c; if (L >= nwg) return false;
        int wgid = (int)L; { const int q = nwg / NXCD, r = nwg % NXCD, xcd = wgid % NXCD, off = wgid / NXCD; wgid = (xcd < r ? xcd * (q + 1) : r * (q + 1) + (xcd - r) * q) + off; }
        const int nig = WGM * nN, gid = wgid / nig, fm = gid * WGM, gsz = (nM - fm) < WGM ? (nM - fm) : WGM;
        u.pm = fm + ((wgid % nig) % gsz); u.pn = (wgid % nig) / gsz; u.type = 0; return true;
    }
    __device__ __forceinline__ void a_ready(const Unit&) const {}
    __device__ __forceinline__ void done(const Unit&) const {}
};

__device__ __forceinline__ unsigned cvt_pk_bf16(float lo, float hi) { unsigned r; asm volatile("v_cvt_pk_bf16_f32 %0, %1, %2" : "=v"(r) : "v"(lo), "v"(hi)); return r; }
typedef float f32x2 __attribute__((ext_vector_type(2)));
template <class Epi, class Sched, bool ALIGN_EPI = false, bool SP2 = false>
__device__ __forceinline__ void gemm_phase(PG8_LAS unsigned char* lds, const Gemm g, const Sched& S, const Epi& E) {
    int tid_ = threadIdx.x; asm volatile("" : "+v"(tid_)); const int tid = tid_, wid = __builtin_amdgcn_readfirstlane(tid >> 6), lane = tid & 63, wr = wid >> 2, wc = wid & 3, fr = lane & 15, fq = lane >> 4;
    const int K = g.K, nt = K / BK;
    unsigned voffA[2], voffB[2];
#pragma unroll
    for (int i = 0; i < 2; ++i) { int R, C; stage_rc(tid * 16 + i * 8192, R, C); const int Rb = Epi::PERM ? ((R & ~31) + perm32(R & 31)) : R;
        voffA[i] = (unsigned)(R * g.lda + C) * 2u; voffB[i] = (unsigned)(Rb * K + C) * 2u; }
    const size_t kstep = (size_t)(BK * 2);
    const size_t hstep = (size_t)HALF * K * 2;
    const size_t tstep = 2 * hstep; const size_t hstepA = (size_t)HALF * g.lda * 2, tstepA = 2 * hstepA;
    const unsigned ldsw = (unsigned)wid * 1024u;
    const int aoff = lds_byte(wr * 64 + fr, fq * 8), boff = lds_byte(wc * 32 + fr, fq * 8);
#define PG8_SA(b, h) (((b) * 2 + (h)) * HTB)
#define PG8_SB(b, h) ((4 + (b) * 2 + (h)) * HTB)
#define PG8_STAGE(bufoff, gbase, voff) do { _Pragma("unroll") for (int _i = 0; _i < 2; ++_i) \
        __builtin_amdgcn_global_load_lds((const unsigned*)((const char*)(gbase) + (voff)[_i]), (PG8_LAS unsigned*)(lds + (bufoff) + ldsw + _i * 8192), 16, 0, 0); } while (0)
#define PG8_LDA(dst, b, h) do { _Pragma("unroll") for (int m = 0; m < 4; ++m) _Pragma("unroll") for (int k = 0; k < 2; ++k) dst[m][k] = *(const PG8_LAS bf16x8*)(lds + PG8_SA(b, h) + aoff + m * 2048 + k * 1024); } while (0)
#define PG8_LDB(dst, b, h) do { _Pragma("unroll") for (int n = 0; n < 2; ++n) _Pragma("unroll") for (int k = 0; k < 2; ++k) dst[n][k] = *(const PG8_LAS bf16x8*)(lds + PG8_SB(b, h) + boff + n * 2048 + k * 1024); } while (0)
#define PG8_MMA(ai, bj, At, Bt) do { __builtin_amdgcn_s_setprio(1); _Pragma("unroll") for (int m = 0; m < 4; ++m) _Pragma("unroll") for (int n = 0; n < 2; ++n) _Pragma("unroll") for (int k = 0; k < 2; ++k) \
        acc[ai][bj][m][n] = __builtin_amdgcn_mfma_f32_16x16x32_bf16(Bt[n][k], At[m][k], acc[ai][bj][m][n], 0, 0, 0); __builtin_amdgcn_s_setprio(0); } while (0)
#define PG8_WAIT_V(n) asm volatile("s_waitcnt vmcnt(" #n ")" ::: "memory")
#define PG8_WAIT_L(n) asm volatile("s_waitcnt lgkmcnt(" #n ")" ::: "memory")
#define PG8_BAR __builtin_amdgcn_s_barrier()
#define PG8_SCHED __builtin_amdgcn_sched_barrier(0)
    Unit cur, nxt; int ui = 0;
    if (!S.next(0, cur)) return;
    f32x4 acc[2][2][4][2];
#pragma unroll
    for (int a = 0; a < 2; ++a)
#pragma unroll
        for (int b = 0; b < 2; ++b)
#pragma unroll
            for (int m = 0; m < 4; ++m)
#pragma unroll
                for (int n = 0; n < 2; ++n) acc[a][b][m][n] = (f32x4){0.f, 0.f, 0.f, 0.f};
    bf16x8 At[4][2], B0[2][2], B1[2][2];
    const char* cA = (const char*)g.A + (size_t)cur.pm * tstepA; const char* cB = (const char*)g.Bt + (size_t)cur.pn * tstep;
    S.a_ready(cur);
    if constexpr (SP2) {
        PG8_STAGE(PG8_SB(0, 0), cB, voffB); PG8_STAGE(PG8_SB(0, 1), cB + hstep, voffB); PG8_STAGE(PG8_SA(0, 0), cA, voffA); PG8_STAGE(PG8_SA(0, 1), cA + hstepA, voffA);
        if (wr == 1) PG8_BAR;
        PG8_WAIT_V(2); PG8_BAR;
        PG8_STAGE(PG8_SB(1, 0), cB + kstep, voffB); PG8_STAGE(PG8_SA(1, 0), cA + kstep, voffA); PG8_STAGE(PG8_SB(1, 1), cB + hstep + kstep, voffB);
        PG8_WAIT_V(6); PG8_BAR;
    } else {
        PG8_STAGE(PG8_SB(0, 0), cB, voffB); PG8_STAGE(PG8_SA(0, 0), cA, voffA); PG8_STAGE(PG8_SB(0, 1), cB + hstep, voffB); PG8_STAGE(PG8_SA(0, 1), cA + hstepA, voffA);
        if (wr == 1) PG8_BAR;
        PG8_WAIT_V(4); PG8_BAR;
        PG8_STAGE(PG8_SB(1, 0), cB + kstep, voffB); PG8_STAGE(PG8_SA(1, 0), cA + kstep, voffA); PG8_STAGE(PG8_SB(1, 1), cB + hstep + kstep, voffB);
        PG8_WAIT_V(6); PG8_BAR;
    }
    for (;;) {
        const bool has_next = S.next(ui + 1, nxt);
        const char* nA = has_next ? (const char*)g.A + (size_t)nxt.pm * tstepA : cA; const char* nB = has_next ? (const char*)g.Bt + (size_t)nxt.pn * tstep : cB;
        for (int t = 0; t < nt; t += 2) {
            const bool last = (t == nt - 2);
            const char* a1 = cA + (size_t)(t + 1) * kstep;
            const char* a2 = last ? nA : cA + (size_t)(t + 2) * kstep; const char* b2 = last ? nB : cB + (size_t)(t + 2) * kstep;
            const char* a3 = a2 + kstep; const char* b3 = b2 + kstep;
            if (last && has_next) S.a_ready(nxt);
            if constexpr (SP2) {
            PG8_LDB(B0, 0, 0); PG8_LDB(B1, 0, 1); PG8_SCHED; PG8_LDA(At, 0, 0); PG8_STAGE(PG8_SA(1, 1), a1 + hstepA, voffA);
            PG8_WAIT_V(8); PG8_WAIT_L(0); PG8_BAR; PG8_MMA(0, 0, At, B0); PG8_MMA(0, 1, At, B1); PG8_BAR; PG8_SCHED;
            PG8_LDA(At, 0, 1); PG8_STAGE(PG8_SB(0, 0), b2, voffB); PG8_STAGE(PG8_SB(0, 1), b2 + hstep, voffB); PG8_STAGE(PG8_SA(0, 0), a2, voffA);
            PG8_WAIT_V(8); PG8_WAIT_L(0); PG8_BAR; PG8_MMA(1, 0, At, B0); PG8_MMA(1, 1, At, B1); PG8_BAR; PG8_SCHED;
            PG8_LDB(B0, 1, 0); PG8_LDB(B1, 1, 1); PG8_SCHED; PG8_LDA(At, 1, 0); PG8_STAGE(PG8_SA(0, 1), a2 + hstepA, voffA);
            PG8_WAIT_V(8); PG8_WAIT_L(0); PG8_BAR; PG8_MMA(0, 0, At, B0); PG8_MMA(0, 1, At, B1); PG8_BAR; PG8_SCHED;
            PG8_LDA(At, 1, 1); PG8_STAGE(PG8_SB(1, 0), b3, voffB); PG8_STAGE(PG8_SB(1, 1), b3 + hstep, voffB); PG8_STAGE(PG8_SA(1, 0), a3, voffA);
            PG8_WAIT_V(8); PG8_WAIT_L(0); PG8_BAR; PG8_MMA(1, 0, At, B0); PG8_MMA(1, 1, At, B1); PG8_BAR; PG8_SCHED;
            } else {
            PG8_LDB(B0, 0, 0); PG8_SCHED; PG8_LDA(At, 0, 0); PG8_STAGE(PG8_SA(1, 1), a1 + hstepA, voffA);
            PG8_WAIT_L(8); PG8_BAR; PG8_WAIT_L(0); PG8_MMA(0, 0, At, B0); PG8_BAR; PG8_SCHED;
            PG8_LDB(B1, 0, 1); PG8_STAGE(PG8_SB(0, 0), b2, voffB);
            PG8_BAR; PG8_WAIT_L(0); PG8_MMA(0, 1, At, B1); PG8_BAR;
            PG8_LDA(At, 0, 1); PG8_STAGE(PG8_SA(0, 0), a2, voffA);
            PG8_BAR; PG8_WAIT_L(0); PG8_MMA(1, 0, At, B0); PG8_BAR; PG8_SCHED;
            PG8_STAGE(PG8_SB(0, 1), b2 + hstep, voffB);
            PG8_WAIT_V(6); PG8_BAR; PG8_MMA(1, 1, At, B1); PG8_BAR;
            PG8_LDB(B0, 1, 0); PG8_SCHED; PG8_LDA(At, 1, 0); PG8_STAGE(PG8_SA(0, 1), a2 + hstepA, voffA);
            PG8_WAIT_L(8); PG8_BAR; PG8_WAIT_L(0); PG8_MMA(0, 0, At, B0); PG8_BAR; PG8_SCHED;
            PG8_LDB(B1, 1, 1); PG8_STAGE(PG8_SB(1, 0), b3, voffB);
            PG8_BAR; PG8_WAIT_L(0); PG8_MMA(0, 1, At, B1); PG8_BAR;
            PG8_LDA(At, 1, 1); PG8_STAGE(PG8_SA(1, 0), a3, voffA);
            PG8_BAR; PG8_WAIT_L(0); PG8_MMA(1, 0, At, B0); PG8_BAR; PG8_SCHED;
            PG8_STAGE(PG8_SB(1, 1), b3 + hstep, voffB);
            PG8_WAIT_V(6); PG8_BAR; PG8_MMA(1, 1, At, B1); PG8_BAR;
            }
        }
        if constexpr (ALIGN_EPI) { if (wr == 0) PG8_BAR; }
        if constexpr (!Epi::AFTER_DRAIN) { int t2_ = threadIdx.x; asm volatile("" : "+v"(t2_)); E(acc, cur, wr, wc, t2_ & 15, (t2_ & 63) >> 4); S.done(cur); }
        if (!has_next) break;
#pragma unroll
        for (int a = 0; a < 2; ++a)
#pragma unroll
            for (int b = 0; b < 2; ++b)
#pragma unroll
                for (int m = 0; m < 4; ++m)
#pragma unroll
                    for (int n = 0; n < 2; ++n) acc[a][b][m][n] = (f32x4){0.f, 0.f, 0.f, 0.f};
        cur = nxt; cA = nA; cB = nB; ++ui;
        if constexpr (ALIGN_EPI) { if (wr == 1) PG8_BAR; }
    }
    PG8_WAIT_V(0);
    if constexpr (!ALIGN_EPI) { if (wr == 0) PG8_BAR; }
    PG8_BAR;
    if constexpr (Epi::AFTER_DRAIN) { E.fused(acc, cur, wr, wc, fr, fq, lds, wid, lane); S.done(cur); }
#undef PG8_SA
#undef PG8_SB
#undef PG8_STAGE
#undef PG8_LDA
#undef PG8_LDB
#undef PG8_MMA
#undef PG8_WAIT_V
#undef PG8_WAIT_L
#undef PG8_BAR
#undef PG8_SCHED
}
}
namespace pg8 {
constexpr size_t KB_OFF = (size_t)373 << 20, VB_OFF = (size_t)380 << 20, ROPE_OFF = 64 * 1024, SK_OFF = (size_t)12288 * 2048, SV_OFF = SK_OFF + 16 * 2 * 256 * 256;
typedef unsigned u32x2e __attribute__((ext_vector_type(2)));
__device__ __forceinline__ float e_lo(unsigned u) { return __uint_as_float(u << 16); }
__device__ __forceinline__ float e_hi(unsigned u) { return __uint_as_float(u & 0xffff0000u); }
__device__ __forceinline__ float e_sig(float x) { return fminf(__expf(-x), 1e30f); }
struct EpiProj {
    static constexpr bool PERM = true, AFTER_DRAIN = false;
    bf16_t* proj; bf16_t* gates; const float* bmerge; int skip; int pn_off;
    unsigned char* ws; float* out; const float* qnw; const float* knw; int l; PG8_LAS float* red;
    __device__ __forceinline__ void head_tiles(const f32x4 (&acc)[2][2][4][2], const Unit& u, int pnn, int wr, int wc, int fr, int fq) const {
        const int rowt = u.pm * BM; const bool lat = rowt >= 4096;
        const int bb = lat ? ((rowt - 4096) >> 11) : (rowt >> 8);
        const int t0 = lat ? ((rowt - 4096) & 2047) : 0;
        const size_t kv0 = lat ? (size_t)4096 + (size_t)bb * 2304 + t0 : (size_t)rowt;
        bf16_t* KB = (bf16_t*)(ws + KB_OFF); bf16_t* VB = (bf16_t*)(ws + VB_OFF);
        if (pnn == 5) {
#pragma unroll
            for (int ai = 0; ai < 2; ++ai)
#pragma unroll
                for (int m = 0; m < 4; ++m) { const int rl = ai * HALF + wr * 64 + m * 16 + fr;
#pragma unroll
                    for (int bj = 0; bj < 2; ++bj) { const int c = bj * HALF + wc * 32 + 8 * fq; const f32x4 v0 = acc[ai][bj][m][0], v1 = acc[ai][bj][m][1];
                        u32x4 w; w.x = cvt_pk_bf16(v0[0], v0[1]); w.y = cvt_pk_bf16(v0[2], v0[3]); w.z = cvt_pk_bf16(v1[0], v1[1]); w.w = cvt_pk_bf16(v1[2], v1[3]);
                        *(u32x4*)(VB + (kv0 + rl) * 256 + c) = w;
                        if (!lat) { float* sv = out + SV_OFF + ((size_t)(bb * 2 + l) * 256 + rl) * 256 + c; *(f32x4*)sv = v0; *(f32x4*)(sv + 4) = v1; } } }
            return; }
        const bool isk = pnn == 4; const float* nw = isk ? knw : qnw;
#pragma unroll
        for (int ai = 0; ai < 2; ++ai)
#pragma unroll
            for (int m = 0; m < 4; ++m) { const int rl = ai * HALF + wr * 64 + m * 16 + fr;
#pragma unroll
                for (int bj = 0; bj < 2; ++bj) { const f32x4 a = acc[ai][bj][m][0], b = acc[ai][bj][m][1];
                    float ss = (a[0] * a[0] + a[1] * a[1]) + (a[2] * a[2] + a[3] * a[3]) + (b[0] * b[0] + b[1] * b[1]) + (b[2] * b[2] + b[3] * b[3]);
                    ss += __shfl_xor(ss, 16); ss += __shfl_xor(ss, 32);
                    if (fq == 0) red[(rl * 2 + bj) * 4 + wc] = ss; } }
        asm volatile("s_waitcnt lgkmcnt(0)" ::: "memory"); __builtin_amdgcn_s_barrier(); asm volatile("" ::: "memory");
        const int q0 = 4 * (4 * wc + fq), base = q0 < 32 ? q0 : q0 + 32;
        const f32x4 w0 = *(const f32x4*)(nw + base), w1 = *(const f32x4*)(nw + base + 32);
        const float* tab = (const float*)(ws + ROPE_OFF);
#pragma unroll
        for (int ai = 0; ai < 2; ++ai)
#pragma unroll
            for (int m = 0; m < 4; ++m) { const int rl = ai * HALF + wr * 64 + m * 16 + fr; const int t = t0 + rl;
                f32x4 cs = {1.f, 1.f, 1.f, 1.f}, sn = {0.f, 0.f, 0.f, 0.f};
                if (lat) { const int pos = q0 < 32 ? (t >> 6) : (t & 63); const float* tp = tab + (size_t)(pos * 32 + (q0 & 31)) * 2;
                    const f32x4 c0 = *(const f32x4*)tp, c1 = *(const f32x4*)(tp + 4); cs = (f32x4){c0[0], c0[2], c1[0], c1[2]}; sn = (f32x4){c0[1], c0[3], c1[1], c1[3]}; }
#pragma unroll
                for (int bj = 0; bj < 2; ++bj) { const f32x4 pr = *(const PG8_LAS f32x4*)(red + (rl * 2 + bj) * 4);
                    const float rstd = 1.f / sqrtf(((pr[0] + pr[1]) + (pr[2] + pr[3])) * (1.f / 128.f) + 1e-6f);
                    f32x4 y0 = acc[ai][bj][m][0] * rstd * w0, y1 = acc[ai][bj][m][1] * rstd * w1;
                    const int hc = bj * HALF + wc * 32 + 8 * fq;
                    if (isk && !lat) { float* sk = out + SK_OFF + ((size_t)(bb * 2 + l) * 256 + rl) * 256 + bj * HALF + base; *(f32x4*)sk = y0; *(f32x4*)(sk + 32) = y1; }
                    const f32x4 o0 = y0 * cs - y1 * sn, o1 = y1 * cs + y0 * sn;
                    u32x4 w; w.x = cvt_pk_bf16(o0[0], o0[1]); w.y = cvt_pk_bf16(o0[2], o0[3]); w.z = cvt_pk_bf16(o1[0], o1[1]); w.w = cvt_pk_bf16(o1[2], o1[3]);
                    if (isk) *(u32x4*)(KB + (kv0 + rl) * 256 + hc) = w;
                    else *(u32x4*)(proj + (size_t)(rowt + rl) * 5120 + pnn * BM + hc) = w; } }
        asm volatile("s_waitcnt lgkmcnt(0)" ::: "memory"); __builtin_amdgcn_s_barrier(); asm volatile("" ::: "memory");
    }
    __device__ __forceinline__ void operator()(const f32x4 (&acc)[2][2][4][2], const Unit& u, int wr, int wc, int fr, int fq) const {
        if (skip) return;
        const int pnn = u.pn + pn_off; const int row0 = u.pm * BM + wr * 64 + fr; const bool isg = pnn >= 20;
        if (pnn < 6) { head_tiles(acc, u, pnn, wr, wc, fr, fq); return; }
        const int colt = (isg ? pnn - 20 : pnn) * BM; const int ld = isg ? 6144 : 5120; bf16_t* base = isg ? gates : proj;
        const int col0 = colt + wc * 32 + 8 * fq;
        f32x4 bv[2][2];
#pragma unroll
        for (int bj = 0; bj < 2; ++bj)
#pragma unroll
            for (int n = 0; n < 2; ++n) bv[bj][n] = isg ? *(const f32x4*)(bmerge + col0 + bj * HALF + 4 * n) : (f32x4){0.f, 0.f, 0.f, 0.f};
#pragma unroll
        for (int ai = 0; ai < 2; ++ai)
#pragma unroll
            for (int m = 0; m < 4; ++m) { bf16_t* rowp = base + (size_t)(row0 + ai * HALF + m * 16) * ld + col0;
                bf16_t* fragp = gates + ((((size_t)u.pm * 24 + (pnn - 20)) * 16 + (ai * 8 + m * 2)) * 512 + ((wr * 4 + wc) * 64 + fq * 16 + fr)) * 8;
#pragma unroll
                for (int bj = 0; bj < 2; ++bj) { f32x4 v0 = acc[ai][bj][m][0] + bv[bj][0], v1 = acc[ai][bj][m][1] + bv[bj][1];
                    if (isg) { v0 = (f32x4){e_sig(v0[0]), e_sig(v0[1]), e_sig(v0[2]), e_sig(v0[3])}; v1 = (f32x4){e_sig(v1[0]), e_sig(v1[1]), e_sig(v1[2]), e_sig(v1[3])}; }
                    u32x4 w; w.x = cvt_pk_bf16(v0[0], v0[1]); w.y = cvt_pk_bf16(v0[2], v0[3]); w.z = cvt_pk_bf16(v1[0], v1[1]); w.w = cvt_pk_bf16(v1[2], v1[3]);
                    if (isg) *(u32x4*)(fragp + bj * 4096) = w; else *(u32x4*)(rowp + bj * HALF) = w; } }
    }
};
struct EpiBranch {
    static constexpr bool PERM = true, AFTER_DRAIN = false;
    bf16_t* merged; const bf16_t* gates; int first;
    __device__ __forceinline__ void operator()(const f32x4 (&acc)[2][2][4][2], const Unit& u, int wr, int wc, int fr, int fq) const {
        const int row0 = u.pm * BM + wr * 64 + fr; const int col0 = u.pn * BM + wc * 32 + 8 * fq;
#pragma unroll
        for (int ai = 0; ai < 2; ++ai)
#pragma unroll
            for (int m = 0; m < 4; ++m) { const size_t row = (size_t)(row0 + ai * HALF + m * 16);
#pragma unroll
                for (int bj = 0; bj < 2; ++bj) { const u32x4 g = *(const u32x4*)(gates + row * 6144 + col0 + bj * HALF); bf16_t* mp = merged + row * 2048 + col0 + bj * HALF;
                    f32x4 v0 = acc[ai][bj][m][0], v1 = acc[ai][bj][m][1];
                    v0 = v0 * (f32x4){e_lo(g.x), e_hi(g.x), e_lo(g.y), e_hi(g.y)}; v1 = v1 * (f32x4){e_lo(g.z), e_hi(g.z), e_lo(g.w), e_hi(g.w)};
                    if (!first) { const u32x4 o = *(const u32x4*)mp; v0 = v0 + (f32x4){e_lo(o.x), e_hi(o.x), e_lo(o.y), e_hi(o.y)}; v1 = v1 + (f32x4){e_lo(o.z), e_hi(o.z), e_lo(o.w), e_hi(o.w)}; }
                    u32x4 w; w.x = cvt_pk_bf16(v0[0], v0[1]); w.y = cvt_pk_bf16(v0[2], v0[3]); w.z = cvt_pk_bf16(v1[0], v1[1]); w.w = cvt_pk_bf16(v1[2], v1[3]);
                    *(u32x4*)mp = w; } }
    }
};
struct EpiResid {
    static constexpr bool PERM = false, AFTER_DRAIN = false;
    const float* xc; const float* xl; float* out; const float* mod;
    __device__ __forceinline__ void operator()(const f32x4 (&acc)[2][2][4][2], const Unit& u, int wr, int wc, int fr, int fq) const {
        const int rowt = u.pm * BM; const int col0 = u.pn * BM + wc * 32 + 4 * fq;
        const float* gate = mod + ((rowt < 4096) ? 0 : 1 + ((rowt - 4096) >> 11)) * 6144 + 4096;
        const float* xo = (rowt < 4096) ? xc : xl - (size_t)4096 * 2048;
        f32x4 gv[2][2];
#pragma unroll
        for (int bj = 0; bj < 2; ++bj)
#pragma unroll
            for (int n = 0; n < 2; ++n) gv[bj][n] = *(const f32x4*)(gate + col0 + bj * HALF + n * 16);
#pragma unroll
        for (int ai = 0; ai < 2; ++ai)
#pragma unroll
            for (int m = 0; m < 4; ++m) { const size_t off = (size_t)(rowt + ai * HALF + wr * 64 + m * 16 + fr) * 2048 + col0;
#pragma unroll
                for (int bj = 0; bj < 2; ++bj)
#pragma unroll
                    for (int n = 0; n < 2; ++n) { const f32x4 xv = *(const f32x4*)(xo + off + bj * HALF + n * 16);
                        *(f32x4*)(out + off + bj * HALF + n * 16) = xv + gv[bj][n] * acc[ai][bj][m][n]; } }
    }
};
struct DeferOrder {
    int G, c;
    __device__ __forceinline__ bool next(int i, Unit& u) const {
        if (G == 256) { const int x = c & 7, j = (c >> 3) + 32 * i; if (j >= 40) return false;
            u.pm = 5 * x + (j >> 3); u.pn = j & 7; u.type = 0; return true; }
        const long t = (long)i * G + c; if (t >= 320) return false; u.pm = (int)(t >> 3); u.pn = (int)(t & 7); u.type = 0; return true; }
    __device__ __forceinline__ void a_ready(const Unit&) const {}
    __device__ __forceinline__ void done(const Unit&) const {}
};
struct Gemm1Order {
    StaticOrder so; int G, c;
    __device__ __forceinline__ void init(int M, int N, int G_, int c_) { so.init(M, N, G_, c_); G = G_; c = c_; }
    __device__ __forceinline__ bool next(int i, Unit& u) const { const long L = (long)i * G + c; if (L < so.nwg) return so.next(i, u); const long e = L - so.nwg; if (e >= 64) return false;
        u.pm = 40 + (int)(e >> 3); u.pn = 36 + (int)(e & 7); u.type = 0; return true; }
    __device__ __forceinline__ void a_ready(const Unit&) const {}
    __device__ __forceinline__ void done(const Unit&) const {}
};
}
namespace pg8 {
struct Gemm2 { const bf16_t* A0; const bf16_t* B0; const bf16_t* A1; const bf16_t* B1; int M, N, K, lda; };
template <class Epi, class Sched, bool ALIGN_EPI = false, bool SP2 = false>
__device__ __forceinline__ void gemm_fused(PG8_LAS unsigned char* lds, const Gemm2 g, const Sched& S, const Epi& E) {
    int tid_ = threadIdx.x; asm volatile("" : "+v"(tid_)); const int tid = tid_, wid = __builtin_amdgcn_readfirstlane(tid >> 6), lane = tid & 63, wr = wid >> 2, wc = wid & 3, fr = lane & 15, fq = lane >> 4;
    const int K = g.K, nt = K / BK;
    unsigned voffA[2], voffB[2];
#pragma unroll
    for (int i = 0; i < 2; ++i) { int R, C; stage_rc(tid * 16 + i * 8192, R, C); const int Rb = Epi::PERM ? ((R & ~31) + perm32(R & 31)) : R;
        voffA[i] = (unsigned)(R * g.lda + C) * 2u; voffB[i] = (unsigned)(Rb * K + C) * 2u; }
    const size_t kstep = (size_t)(BK * 2);
    const size_t hstep = (size_t)HALF * K * 2;
    const size_t tstep = 2 * hstep; const size_t hstepA = (size_t)HALF * g.lda * 2, tstepA = 2 * hstepA;
    const unsigned ldsw = (unsigned)wid * 1024u;
    const int aoff = lds_byte(wr * 64 + fr, fq * 8), boff = lds_byte(wc * 32 + fr, fq * 8);
#define PG8_SA(b, h) (((b) * 2 + (h)) * HTB)
#define PG8_SB(b, h) ((4 + (b) * 2 + (h)) * HTB)
#define PG8_STAGE(bufoff, gbase, voff) do { _Pragma("unroll") for (int _i = 0; _i < 2; ++_i) \
        __builtin_amdgcn_global_load_lds((const unsigned*)((const char*)(gbase) + (voff)[_i]), (PG8_LAS unsigned*)(lds + (bufoff) + ldsw + _i * 8192), 16, 0, 0); } while (0)
#define PG8_LDA(dst, b, h) do { _Pragma("unroll") for (int m = 0; m < 4; ++m) _Pragma("unroll") for (int k = 0; k < 2; ++k) dst[m][k] = *(const PG8_LAS bf16x8*)(lds + PG8_SA(b, h) + aoff + m * 2048 + k * 1024); } while (0)
#define PG8_LDB(dst, b, h) do { _Pragma("unroll") for (int n = 0; n < 2; ++n) _Pragma("unroll") for (int k = 0; k < 2; ++k) dst[n][k] = *(const PG8_LAS bf16x8*)(lds + PG8_SB(b, h) + boff + n * 2048 + k * 1024); } while (0)
#define PG8_MMA(ai, bj, At, Bt) do { __builtin_amdgcn_s_setprio(1); _Pragma("unroll") for (int m = 0; m < 4; ++m) _Pragma("unroll") for (int n = 0; n < 2; ++n) _Pragma("unroll") for (int k = 0; k < 2; ++k) \
        acc[ai][bj][m][n] = __builtin_amdgcn_mfma_f32_16x16x32_bf16(Bt[n][k], At[m][k], acc[ai][bj][m][n], 0, 0, 0); __builtin_amdgcn_s_setprio(0); } while (0)
#define PG8_WAIT_V(n) asm volatile("s_waitcnt vmcnt(" #n ")" ::: "memory")
#define PG8_WAIT_L(n) asm volatile("s_waitcnt lgkmcnt(" #n ")" ::: "memory")
#define PG8_BAR __builtin_amdgcn_s_barrier()
#define PG8_SCHED __builtin_amdgcn_sched_barrier(0)
    Unit cur, nxt; int ui = 0;
    if (!S.next(0, cur)) return;
    f32x4 acc[2][2][4][2];
#pragma unroll
    for (int a = 0; a < 2; ++a)
#pragma unroll
        for (int b = 0; b < 2; ++b)
#pragma unroll
            for (int m = 0; m < 4; ++m)
#pragma unroll
                for (int n = 0; n < 2; ++n) acc[a][b][m][n] = (f32x4){0.f, 0.f, 0.f, 0.f};
    bf16x8 At[4][2], B0[2][2], B1[2][2];
    const char* cA = (const char*)(cur.type ? g.A1 : g.A0) + (size_t)cur.pm * tstepA; const char* cB = (const char*)(cur.type ? g.B1 : g.B0) + (size_t)cur.pn * tstep;
    S.a_ready(cur);
    if constexpr (SP2) {
        PG8_STAGE(PG8_SB(0, 0), cB, voffB); PG8_STAGE(PG8_SB(0, 1), cB + hstep, voffB); PG8_STAGE(PG8_SA(0, 0), cA, voffA); PG8_STAGE(PG8_SA(0, 1), cA + hstepA, voffA);
        if (wr == 1) PG8_BAR;
        PG8_WAIT_V(2); PG8_BAR;
        PG8_STAGE(PG8_SB(1, 0), cB + kstep, voffB); PG8_STAGE(PG8_SA(1, 0), cA + kstep, voffA); PG8_STAGE(PG8_SB(1, 1), cB + hstep + kstep, voffB);
        PG8_WAIT_V(6); PG8_BAR;
    } else {
        PG8_STAGE(PG8_SB(0, 0), cB, voffB); PG8_STAGE(PG8_SA(0, 0), cA, voffA); PG8_STAGE(PG8_SB(0, 1), cB + hstep, voffB); PG8_STAGE(PG8_SA(0, 1), cA + hstepA, voffA);
        if (wr == 1) PG8_BAR;
        PG8_WAIT_V(4); PG8_BAR;
        PG8_STAGE(PG8_SB(1, 0), cB + kstep, voffB); PG8_STAGE(PG8_SA(1, 0), cA + kstep, voffA); PG8_STAGE(PG8_SB(1, 1), cB + hstep + kstep, voffB);
        PG8_WAIT_V(6); PG8_BAR;
    }
    for (;;) {
        const bool has_next = S.next(ui + 1, nxt);
        const char* nA = has_next ? (const char*)(nxt.type ? g.A1 : g.A0) + (size_t)nxt.pm * tstepA : cA; const char* nB = has_next ? (const char*)(nxt.type ? g.B1 : g.B0) + (size_t)nxt.pn * tstep : cB;
        for (int t = 0; t < nt; t += 2) {
            const bool last = (t == nt - 2);
            const char* a1 = cA + (size_t)(t + 1) * kstep;
            const char* a2 = last ? nA : cA + (size_t)(t + 2) * kstep; const char* b2 = last ? nB : cB + (size_t)(t + 2) * kstep;
            const char* a3 = a2 + kstep; const char* b3 = b2 + kstep;
            if (last && has_next) S.a_ready(nxt);
            if constexpr (SP2) {
            PG8_LDB(B0, 0, 0); PG8_LDB(B1, 0, 1); PG8_SCHED; PG8_LDA(At, 0, 0); PG8_STAGE(PG8_SA(1, 1), a1 + hstepA, voffA);
            PG8_WAIT_V(8); PG8_WAIT_L(0); PG8_BAR; PG8_MMA(0, 0, At, B0); PG8_MMA(0, 1, At, B1); PG8_BAR; PG8_SCHED;
            PG8_LDA(At, 0, 1); PG8_STAGE(PG8_SB(0, 0), b2, voffB); PG8_STAGE(PG8_SB(0, 1), b2 + hstep, voffB); PG8_STAGE(PG8_SA(0, 0), a2, voffA);
            PG8_WAIT_V(8); PG8_WAIT_L(0); PG8_BAR; PG8_MMA(1, 0, At, B0); PG8_MMA(1, 1, At, B1); PG8_BAR; PG8_SCHED;
            PG8_LDB(B0, 1, 0); PG8_LDB(B1, 1, 1); PG8_SCHED; PG8_LDA(At, 1, 0); PG8_STAGE(PG8_SA(0, 1), a2 + hstepA, voffA);
            PG8_WAIT_V(8); PG8_WAIT_L(0); PG8_BAR; PG8_MMA(0, 0, At, B0); PG8_MMA(0, 1, At, B1); PG8_BAR; PG8_SCHED;
            PG8_LDA(At, 1, 1); PG8_STAGE(PG8_SB(1, 0), b3, voffB); PG8_STAGE(PG8_SB(1, 1), b3 + hstep, voffB); PG8_STAGE(PG8_SA(1, 0), a3, voffA);
            PG8_WAIT_V(8); PG8_WAIT_L(0); PG8_BAR; PG8_MMA(1, 0, At, B0); PG8_MMA(1, 1, At, B1); PG8_BAR; PG8_SCHED;
            } else {
            PG8_LDB(B0, 0, 0); PG8_SCHED; PG8_LDA(At, 0, 0); PG8_STAGE(PG8_SA(1, 1), a1 + hstepA, voffA);
            PG8_WAIT_L(8); PG8_BAR; PG8_WAIT_L(0); PG8_MMA(0, 0, At, B0); PG8_BAR; PG8_SCHED;
            PG8_LDB(B1, 0, 1); PG8_STAGE(PG8_SB(0, 0), b2, voffB);
            PG8_BAR; PG8_WAIT_L(0); PG8_MMA(0, 1, At, B1); PG8_BAR;
            PG8_LDA(At, 0, 1); PG8_STAGE(PG8_SA(0, 0), a2, voffA);
            PG8_BAR; PG8_WAIT_L(0); PG8_MMA(1, 0, At, B0); PG8_BAR; PG8_SCHED;
            PG8_STAGE(PG8_SB(0, 1), b2 + hstep, voffB);
            PG8_WAIT_V(6); PG8_BAR; PG8_MMA(1, 1, At, B1); PG8_BAR;
            PG8_LDB(B0, 1, 0); PG8_SCHED; PG8_LDA(At, 1, 0); PG8_STAGE(PG8_SA(0, 1), a2 + hstepA, voffA);
            PG8_WAIT_L(8); PG8_BAR; PG8_WAIT_L(0); PG8_MMA(0, 0, At, B0); PG8_BAR; PG8_SCHED;
            PG8_LDB(B1, 1, 1); PG8_STAGE(PG8_SB(1, 0), b3, voffB);
            PG8_BAR; PG8_WAIT_L(0); PG8_MMA(0, 1, At, B1); PG8_BAR;
            PG8_LDA(At, 1, 1); PG8_STAGE(PG8_SA(1, 0), a3, voffA);
            PG8_BAR; PG8_WAIT_L(0); PG8_MMA(1, 0, At, B0); PG8_BAR; PG8_SCHED;
            PG8_STAGE(PG8_SB(1, 1), b3 + hstep, voffB);
            PG8_WAIT_V(6); PG8_BAR; PG8_MMA(1, 1, At, B1); PG8_BAR;
            }
            if (cur.type == 0 && (t == 14 || t == 22)) { int t3_ = threadIdx.x; asm volatile("" : "+v"(t3_)); E.mid(acc, cur, wr, wc, t3_ & 15, (t3_ & 63) >> 4, t == 14 ? 0 : 1); }
        }
        if constexpr (ALIGN_EPI) { if (wr == 0) PG8_BAR; }
        if constexpr (!Epi::AFTER_DRAIN) { int t2_ = threadIdx.x; asm volatile("" : "+v"(t2_)); E(acc, cur, wr, wc, t2_ & 15, (t2_ & 63) >> 4); S.done(cur); }
        if (!has_next) break;
#pragma unroll
        for (int a = 0; a < 2; ++a)
#pragma unroll
            for (int b = 0; b < 2; ++b)
#pragma unroll
                for (int m = 0; m < 4; ++m)
#pragma unroll
                    for (int n = 0; n < 2; ++n) acc[a][b][m][n] = (f32x4){0.f, 0.f, 0.f, 0.f};
        cur = nxt; cA = nA; cB = nB; ++ui;
        if constexpr (ALIGN_EPI) { if (wr == 1) PG8_BAR; }
    }
    PG8_WAIT_V(0);
    if constexpr (!ALIGN_EPI) { if (wr == 0) PG8_BAR; }
    PG8_BAR;
    if constexpr (Epi::AFTER_DRAIN) { E.fused(acc, cur, wr, wc, fr, fq, lds, wid, lane); S.done(cur); }
#undef PG8_SA
#undef PG8_SB
#undef PG8_STAGE
#undef PG8_LDA
#undef PG8_LDB
#undef PG8_MMA
#undef PG8_WAIT_V
#undef PG8_WAIT_L
#undef PG8_BAR
#undef PG8_SCHED
}
}
namespace pg8 {
__device__ __forceinline__ void store16_sc1(void* p, u32x4 v) { asm volatile("global_store_dwordx4 %0, %1, off sc1\n\ts_nop 1" :: "v"(p), "v"(v)); }
#ifndef MK_WT
#define MK_WT 1
#endif
#if MK_WT
#define MK_ST16(p, v) store16_sc1((p), (v))
#define MK_PUBLISH_FENCE do {} while (0)
#else
#define MK_ST16(p, v) (*(u32x4*)(p) = (v))
#define MK_PUBLISH_FENCE __builtin_amdgcn_fence(__ATOMIC_RELEASE, "agent")
#endif
struct FusedOrder {
    int G, c; unsigned* cnt;
    __device__ __forceinline__ bool next(int i, Unit& u) const {
        if (G == 256) { if (i >= 3) return false; const int h = c >> 7, idx = c & 127, x = idx & 7, j = idx >> 3;
            u.type = (i == 0) ? 0 : (i == 1 ? h : 1);
            const int p0 = (i == 0) ? 16 * h : (i == 1 ? (h ? 0 : 32) : (h ? 32 : 16));
            u.pm = p0 + 4 * (x >> 1) + (j >> 2); u.pn = 4 * (x & 1) + (j & 3); return true; }
        const long L = (long)i * G + c; if (L >= 768) return false;
        u.type = L >= 384; const int t = (int)(L % 384); u.pm = t >> 3; u.pn = t & 7; return true;
    }
    __device__ __forceinline__ void a_ready(const Unit& u) const {
        if (u.type == 0) return;
        if (threadIdx.x < 64) {
            unsigned polls = 0;
            while ((unsigned)__builtin_amdgcn_readfirstlane(__hip_atomic_load(cnt + 64 * u.pm, __ATOMIC_RELAXED, __HIP_MEMORY_SCOPE_AGENT)) < 64u) {
                if (++polls > (1u << 20)) break;
                __builtin_amdgcn_s_sleep(2); }
            __builtin_amdgcn_fence(__ATOMIC_ACQUIRE, "agent");
            asm volatile("s_waitcnt vmcnt(0)" ::: "memory");
        }
        asm volatile("" ::: "memory"); __builtin_amdgcn_s_barrier(); asm volatile("" ::: "memory");
    }
    __device__ __forceinline__ void done(const Unit& u) const {
        if (u.type != 0) return;
        asm volatile("s_waitcnt vmcnt(0)" ::: "memory");
        if ((threadIdx.x & 63) == 0) __hip_atomic_fetch_add(cnt + 64 * u.pm, 1u, __ATOMIC_RELAXED, __HIP_MEMORY_SCOPE_AGENT);
    }
};
struct EpiFused {
    static constexpr bool PERM = true, AFTER_DRAIN = false;
    unsigned char* ws; const float* xc; const float* xl; float* out; int l; size_t o_merged, o_gates, o_mod; int probe;
    __device__ __forceinline__ void mid(f32x4 (&acc)[2][2][4][2], const Unit& u, int wr, int wc, int fr, int fq, int br) const {
        const int tidf = (wr * 4 + wc) * 64 + fq * 16 + fr; const bf16_t* gates = (const bf16_t*)(ws + o_gates);
#pragma unroll
        for (int ai = 0; ai < 2; ++ai)
            {
                u32x4 a[4][2], b[4][2];
#pragma unroll
                for (int m = 0; m < 4; ++m) { const bf16_t* gp = gates + ((((size_t)u.pm * 24 + (br * 8 + u.pn)) * 16 + (ai * 8 + m * 2)) * 512 + tidf) * 8;
#pragma unroll
                    for (int bj = 0; bj < 2; ++bj) { a[m][bj] = *(const u32x4*)(gp + bj * 4096); b[m][bj] = *(const u32x4*)(gp + bj * 4096 + (size_t)8 * 16 * 512 * 8); } }
                __builtin_amdgcn_sched_barrier(0);
#pragma unroll
                for (int m = 0; m < 4; ++m)
#pragma unroll
                    for (int bj = 0; bj < 2; ++bj) { const u32x4 x = a[m][bj], y = b[m][bj];
                        acc[ai][bj][m][0] = acc[ai][bj][m][0] * (f32x4){(1.f + e_lo(y.x)) * __builtin_amdgcn_rcpf(1.f + e_lo(x.x)), (1.f + e_hi(y.x)) * __builtin_amdgcn_rcpf(1.f + e_hi(x.x)), (1.f + e_lo(y.y)) * __builtin_amdgcn_rcpf(1.f + e_lo(x.y)), (1.f + e_hi(y.y)) * __builtin_amdgcn_rcpf(1.f + e_hi(x.y))};
                        acc[ai][bj][m][1] = acc[ai][bj][m][1] * (f32x4){(1.f + e_lo(y.z)) * __builtin_amdgcn_rcpf(1.f + e_lo(x.z)), (1.f + e_hi(y.z)) * __builtin_amdgcn_rcpf(1.f + e_hi(x.z)), (1.f + e_lo(y.w)) * __builtin_amdgcn_rcpf(1.f + e_lo(x.w)), (1.f + e_hi(y.w)) * __builtin_amdgcn_rcpf(1.f + e_hi(x.w))}; }
                __builtin_amdgcn_sched_barrier(0);
            }
    }
    __device__ __forceinline__ void operator()(const f32x4 (&acc)[2][2][4][2], const Unit& u, int wr, int wc, int fr, int fq) const {
        const int rowt = u.pm * BM; const int row0 = rowt + wr * 64 + fr; const int col0 = u.pn * BM + wc * 32 + 8 * fq;
        if (u.type == 0) { const bf16_t* gates = (const bf16_t*)(ws + o_gates); bf16_t* merged = (bf16_t*)(ws + o_merged);
#pragma unroll
            for (int ai = 0; ai < 2; ++ai) { u32x4 g[4][2];
#pragma unroll
                for (int m = 0; m < 4; ++m)
#pragma unroll
                    for (int bj = 0; bj < 2; ++bj) g[m][bj] = *(const u32x4*)(gates + ((((size_t)u.pm * 24 + (16 + u.pn)) * 16 + (ai * 8 + m * 2 + bj)) * 512 + ((wr * 4 + wc) * 64 + fq * 16 + fr)) * 8);
                __builtin_amdgcn_sched_barrier(0);
#pragma unroll
                for (int m = 0; m < 4; ++m) { const size_t row = (size_t)(row0 + ai * HALF + m * 16);
#pragma unroll
                    for (int bj = 0; bj < 2; ++bj) { const u32x4 gg = g[m][bj];
                        const f32x4 v0 = acc[ai][bj][m][0] * (f32x4){__builtin_amdgcn_rcpf(1.f + e_lo(gg.x)), __builtin_amdgcn_rcpf(1.f + e_hi(gg.x)), __builtin_amdgcn_rcpf(1.f + e_lo(gg.y)), __builtin_amdgcn_rcpf(1.f + e_hi(gg.y))}, v1 = acc[ai][bj][m][1] * (f32x4){__builtin_amdgcn_rcpf(1.f + e_lo(gg.z)), __builtin_amdgcn_rcpf(1.f + e_hi(gg.z)), __builtin_amdgcn_rcpf(1.f + e_lo(gg.w)), __builtin_amdgcn_rcpf(1.f + e_hi(gg.w))};
                        u32x4 w; w.x = cvt_pk_bf16(v0[0], v0[1]); w.y = cvt_pk_bf16(v0[2], v0[3]); w.z = cvt_pk_bf16(v1[0], v1[1]); w.w = cvt_pk_bf16(v1[2], v1[3]);
                        store16_sc1(merged + row * 2048 + col0 + bj * HALF, w); } }
                __builtin_amdgcn_sched_barrier(0); }
        } else {
            const float* mod = (const float*)(ws + o_mod) + (size_t)l * 5 * 6144; const float* gate = mod + ((rowt < 4096) ? 0 : 1 + ((rowt - 4096) >> 11)) * 6144 + 4096;
            const float* xo = (rowt < 4096) ? xc : xl - (size_t)4096 * 2048;
            f32x4 gv[2][2];
#pragma unroll
            for (int bj = 0; bj < 2; ++bj)
#pragma unroll
                for (int n = 0; n < 2; ++n) gv[bj][n] = *(const f32x4*)(gate + col0 + bj * HALF + 4 * n);
            unsigned ob1 = (unsigned)(row0 * 2048 + col0) * 4u; asm volatile("" : "+v"(ob1));
#pragma unroll
            for (int ai = 0; ai < 2; ++ai)
#pragma unroll
              for (int mh = 0; mh < 2; ++mh) {
                f32x4 xv[2][2][2];
#pragma unroll
                for (int m2 = 0; m2 < 2; ++m2) { const unsigned ob = ob1 + (unsigned)(ai * HALF + (mh * 2 + m2) * 16) * 8192u;
#pragma unroll
                    for (int bj = 0; bj < 2; ++bj)
#pragma unroll
                        for (int n = 0; n < 2; ++n) xv[m2][bj][n] = *(const f32x4*)((const char*)xo + (size_t)(ob + (unsigned)(bj * HALF + 4 * n) * 4u)); }
                __builtin_amdgcn_sched_barrier(0);
#pragma unroll
                for (int m2 = 0; m2 < 2; ++m2) { const int m = mh * 2 + m2; const unsigned ob = ob1 + (unsigned)(ai * HALF + m * 16) * 8192u;
#pragma unroll
                    for (int bj = 0; bj < 2; ++bj)
#pragma unroll
                        for (int n = 0; n < 2; ++n) { if (!probe) *(f32x4*)((char*)out + (size_t)(ob + (unsigned)(bj * HALF + 4 * n) * 4u)) = xv[m2][bj][n] + gv[bj][n] * acc[ai][bj][m][n]; } }
                asm volatile("" ::: "memory"); }
        }
    }
};
}
namespace att {
using bf16 = __hip_bfloat16;
constexpr int   D = 128, NW = 8, QBLK = 32, KVBLK = 64;
constexpr float SCALE = 0.088388347648318440f;
constexpr float THR = 8.f;
constexpr int SDEPTH = 2;
constexpr int LDQ = 5120, LDK = 256, LDO = 2048;
constexpr size_t SHM_V = KVBLK * D * 2, SHM_K = KVBLK * D * 2, SHM_ATTN = 2 * SHM_V + 2 * SHM_K + NW * 64 * 4;
constexpr int STG_OFF = (int)SHM_ATTN, STG_WAVE = 32 * 272;
using bf16x8 = __attribute__((ext_vector_type(8))) short;
using s16x4  = __attribute__((ext_vector_type(4))) short;
using f32x16 = __attribute__((ext_vector_type(16))) float;
using f32x8  = __attribute__((ext_vector_type(8))) float;
using u32x4  = __attribute__((ext_vector_type(4))) unsigned;
#define KSWZ(row, colB) ((row) * 256 + ((colB) ^ (((row) & 7) << 4)))
#define SBAR() __builtin_amdgcn_sched_barrier(0)
__device__ __forceinline__ int crow(int r, int hi) { return (r & 3) + 8 * (r >> 2) + 4 * hi; }
__device__ __forceinline__ unsigned cvtpk(float lo, float hi) {
  unsigned r; asm volatile("v_cvt_pk_bf16_f32 %0, %1, %2" : "=v"(r) : "v"(lo), "v"(hi)); return r;
}
template <typename TIn> struct Stage;
template <> struct Stage<bf16>  { using T = bf16x8;
  __device__ static __forceinline__ T ld8(const bf16* p) { return *reinterpret_cast<const bf16x8*>(p); }
  __device__ static __forceinline__ bf16x8 tobf(T x) { return x; } };
template <> struct Stage<float> { using T = f32x8;
  __device__ static __forceinline__ T ld8(const float* p) { return *reinterpret_cast<const f32x8*>(p); }
  __device__ static __forceinline__ bf16x8 tobf(T x) {
    u32x4 w = {cvtpk(x[0], x[1]), cvtpk(x[2], x[3]), cvtpk(x[4], x[5]), cvtpk(x[6], x[7])}; return *reinterpret_cast<bf16x8*>(&w); } };

__device__ __forceinline__ void partialSM(f32x16& p0, f32x16& p1, float& m_reg, float& mn, float& alpha) {
  constexpr float C = SCALE * 1.4426950408889634f;
  float pmax = p0[0]; for (int r = 1; r < 16; ++r) pmax = fmaxf(pmax, p0[r]); for (int r = 0; r < 16; ++r) pmax = fmaxf(pmax, p1[r]);
  { auto rr = __builtin_amdgcn_permlane32_swap(__float_as_uint(pmax), __float_as_uint(pmax), false, false);
    pmax = fmaxf(__uint_as_float(rr[0]), __uint_as_float(rr[1])); }
  if (__builtin_expect(__all(pmax - m_reg <= THR / SCALE), 1)) { mn = m_reg; alpha = 1.f; }
  else { mn = fmaxf(m_reg, pmax); alpha = __builtin_amdgcn_exp2f((m_reg - mn) * C); m_reg = mn; }
  float mnC = -mn * C;
  for (int r = 0; r < 16; ++r) p0[r] = fmaf(p0[r], C, mnC); for (int r = 0; r < 16; ++r) p1[r] = fmaf(p1[r], C, mnC);
  for (int r = 0; r < 16; ++r) p0[r] = __builtin_amdgcn_exp2f(p0[r]);
}
__device__ __forceinline__ void finishSM(f32x16& p0, f32x16& p1, float alpha, float& l_reg, bf16x8& pa0, bf16x8& pa1, bf16x8& pa2, bf16x8& pa3) {
  for (int r = 0; r < 16; ++r) p1[r] = __builtin_amdgcn_exp2f(p1[r]);
  float ps = 0; for (int r = 0; r < 16; ++r) ps += p0[r]; for (int r = 0; r < 16; ++r) ps += p1[r];
  { auto rr = __builtin_amdgcn_permlane32_swap(__float_as_uint(ps), __float_as_uint(ps), false, false);
    ps = __uint_as_float(rr[0]) + __uint_as_float(rr[1]); }
  l_reg = l_reg * alpha + ps;
#define PK4(P, BASE, OUT) do { unsigned a0 = cvtpk(P[BASE + 0], P[BASE + 1]), a1 = cvtpk(P[BASE + 2], P[BASE + 3]);   \
    unsigned b0 = cvtpk(P[BASE + 4], P[BASE + 5]), b1 = cvtpk(P[BASE + 6], P[BASE + 7]);                              \
    auto r0 = __builtin_amdgcn_permlane32_swap(a0, b0, false, false); auto r1 = __builtin_amdgcn_permlane32_swap(a1, b1, false, false); \
    u32x4 w = {r0[0], r1[0], r0[1], r1[1]}; OUT = *reinterpret_cast<bf16x8*>(&w); } while (0)
  PK4(p0, 0, pa0); PK4(p0, 8, pa1); PK4(p1, 0, pa2); PK4(p1, 8, pa3);
#undef PK4
}
__device__ __forceinline__ void qkt(f32x16& p0, f32x16& p1, const bf16* Ks, const bf16x8* qr, int r32, int hi) {
  p0 = f32x16{}; p1 = f32x16{};
  for (int d0 = 0; d0 < 8; ++d0) { int cb = (d0 * 16 + hi * 8) * 2;
    bf16x8 b0 = *reinterpret_cast<const bf16x8*>((const char*)Ks + KSWZ(r32, cb));
    bf16x8 b1 = *reinterpret_cast<const bf16x8*>((const char*)Ks + KSWZ(32 + r32, cb));
    p0 = __builtin_amdgcn_mfma_f32_32x32x16_bf16(b0, qr[d0], p0, 0, 0, 0);
    p1 = __builtin_amdgcn_mfma_f32_32x32x16_bf16(b1, qr[d0], p1, 0, 0, 0); }
}
__device__ __forceinline__ int v_st(int k, int c) { const int kk = (k & ~0xC) | ((k & 4) << 1) | ((k & 8) >> 1); return ((kk >> 3) * 4 + (c >> 5)) * 512 + ((kk & 7) * 32 + (c & 31)) * 2; }
__device__ __forceinline__ int v_rd_base(int lane) { return ((lane & 3) << 3) | (((lane >> 2) & 3) << 6) | (((lane >> 4) & 1) << 5) | (((lane >> 5) & 1) << 8); }
constexpr int v_rd_off(int d0, int ks, int half) { return d0 * 512 + ks * 4096 + half * 2048; }
template <int OFF> __device__ __forceinline__ s16x4 tr_read(int vb) {
  s16x4 r; asm volatile("ds_read_b64_tr_b16 %0, %1 offset:%2" : "=&v"(r) : "v"(vb), "i"(OFF) : "memory"); return r;
}
template <int D0> __device__ __forceinline__ void pv_one(f32x16& od, int vb, bf16x8 pa0, bf16x8 pa1, bf16x8 pa2, bf16x8 pa3) {
  const s16x4 l0 = tr_read<v_rd_off(D0, 0, 0)>(vb), h0 = tr_read<v_rd_off(D0, 0, 1)>(vb), l1 = tr_read<v_rd_off(D0, 1, 0)>(vb), h1 = tr_read<v_rd_off(D0, 1, 1)>(vb);
  const s16x4 l2 = tr_read<v_rd_off(D0, 2, 0)>(vb), h2 = tr_read<v_rd_off(D0, 2, 1)>(vb), l3 = tr_read<v_rd_off(D0, 3, 0)>(vb), h3 = tr_read<v_rd_off(D0, 3, 1)>(vb);
  asm volatile("s_waitcnt lgkmcnt(0)" ::: "memory"); SBAR();
#define PK(L, H) (bf16x8){L[0], L[1], L[2], L[3], H[0], H[1], H[2], H[3]}
  od = __builtin_amdgcn_mfma_f32_32x32x16_bf16(pa0, PK(l0, h0), od, 0, 0, 0);
  od = __builtin_amdgcn_mfma_f32_32x32x16_bf16(pa1, PK(l1, h1), od, 0, 0, 0);
  od = __builtin_amdgcn_mfma_f32_32x32x16_bf16(pa2, PK(l2, h2), od, 0, 0, 0);
  od = __builtin_amdgcn_mfma_f32_32x32x16_bf16(pa3, PK(l3, h3), od, 0, 0, 0);
#undef PK
}
__device__ __forceinline__ void pv_d0(f32x16* o, int vb, bf16x8 pa0, bf16x8 pa1, bf16x8 pa2, bf16x8 pa3) {
  pv_one<0>(o[0], vb, pa0, pa1, pa2, pa3); pv_one<1>(o[1], vb, pa0, pa1, pa2, pa3); pv_one<2>(o[2], vb, pa0, pa1, pa2, pa3); pv_one<3>(o[3], vb, pa0, pa1, pa2, pa3);
}

template <typename TQ>
__device__ __forceinline__ void attn_dense_body(const TQ* Qb, const bf16* __restrict__ Kh, const bf16* __restrict__ Vh,
                                                const bf16* __restrict__ Gb, bf16* __restrict__ Ob, int seq, char* lds) {
  using St = Stage<bf16>; using SQ = Stage<TQ>;
  int tid_ = threadIdx.x; asm volatile("" : "+v"(tid_)); const int tid = tid_, wid = __builtin_amdgcn_readfirstlane(tid >> 6), lane = tid & 63, r32 = lane & 31, hi = lane >> 5;
  bf16* V_lds = (bf16*)lds; bf16* K_lds = (bf16*)(lds + 2 * SHM_V);
  float* ws = (float*)(lds + 2 * SHM_V + 2 * SHM_K) + wid * 64; float* li_l = ws; float* al_l = ws + 32;
  float m_reg = -1e30f, l_reg = 0; f32x16 o[4] = {}; bf16x8 qr[8];
  const TQ* Qw = Qb + (long)(wid * QBLK + r32) * LDQ + hi * 8;
#pragma unroll
  for (int d0 = 0; d0 < 8; ++d0) qr[d0] = SQ::tobf(SQ::ld8(Qw + d0 * 16));
  const int sr = tid >> 4, sc = (tid & 15) * 8, vst0 = v_st(sr, sc), vst1 = v_st(32 + sr, sc);
  const int vb0 = (int)(uintptr_t)V_lds + v_rd_base(lane);
  struct { typename St::T vs0, vs1, ks0, ks1; } sr_[SDEPTH];
#define SLOAD(i, k0) do { sr_[i].vs0 = St::ld8(&Vh[(long)((k0) + sr) * LDK + sc]); sr_[i].vs1 = St::ld8(&Vh[(long)((k0) + 32 + sr) * LDK + sc]); \
    sr_[i].ks0 = St::ld8(&Kh[(long)((k0) + sr) * LDK + sc]); sr_[i].ks1 = St::ld8(&Kh[(long)((k0) + 32 + sr) * LDK + sc]); } while (0)
#define SWRITE(b, i) do { *(bf16x8*)((char*)V_lds + (b) * SHM_V + vst0) = St::tobf(sr_[i].vs0);          \
    *(bf16x8*)((char*)V_lds + (b) * SHM_V + vst1) = St::tobf(sr_[i].vs1); int kc = sc * 2;               \
    *(bf16x8*)((char*)K_lds + (b) * SHM_K + KSWZ(sr, kc)) = St::tobf(sr_[i].ks0);                       \
    *(bf16x8*)((char*)K_lds + (b) * SHM_K + KSWZ(32 + sr, kc)) = St::tobf(sr_[i].ks1); } while (0)
#define SWAIT() do { if constexpr (SDEPTH == 2) asm volatile("s_waitcnt vmcnt(4)" ::: "memory"); else asm volatile("s_waitcnt vmcnt(0)" ::: "memory"); } while (0)
#define RESC(a) do { if (__any((a) < 1.f)) { if (hi == 0) al_l[r32] = (a); asm volatile("s_waitcnt lgkmcnt(0)" ::: "memory"); \
    for (int d = 0; d < 4; ++d) for (int r = 0; r < 16; ++r) o[d][r] *= al_l[crow(r, hi)]; } } while (0)
  f32x16 pA0, pA1, pB0, pB1; float mnA, mnB, alA, alB; bf16x8 pa0, pa1, pa2, pa3; const int NT = seq / KVBLK;
  constexpr int SE = 0, SO = SDEPTH - 1;
  SLOAD(SE, 0); asm volatile("s_waitcnt vmcnt(0)" ::: "memory"); SWRITE(0, SE); __syncthreads();
  qkt(pA0, pA1, K_lds, qr, r32, hi); partialSM(pA0, pA1, m_reg, mnA, alA);
  SLOAD(SO, KVBLK); if constexpr (SDEPTH == 2) { if (2 < NT) SLOAD(SE, 2 * KVBLK); }
  SWAIT(); SWRITE(1, SO); __syncthreads();
  for (int j = 1; j + 1 < NT; j += 2) {
    SBAR(); qkt(pB0, pB1, (bf16*)((char*)K_lds + SHM_K), qr, r32, hi);
    finishSM(pA0, pA1, alA, l_reg, pa0, pa1, pa2, pa3); SBAR();
    SLOAD(SO, (j + SDEPTH) * KVBLK); SBAR();
    pv_d0(o, vb0, pa0, pa1, pa2, pa3); partialSM(pB0, pB1, m_reg, mnB, alB);
    __syncthreads(); SWAIT(); SWRITE(0, SE);
    RESC(alB); __syncthreads();
    SBAR(); qkt(pA0, pA1, K_lds, qr, r32, hi);
    finishSM(pB0, pB1, alB, l_reg, pa0, pa1, pa2, pa3); SBAR();
    if (SDEPTH == 1 || j + 3 < NT) SLOAD(SE, (j + 1 + SDEPTH) * KVBLK); SBAR();
    pv_d0(o, vb0 + (int)SHM_V, pa0, pa1, pa2, pa3); partialSM(pA0, pA1, m_reg, mnA, alA);
    __syncthreads(); SWAIT(); SWRITE(1, SO);
    RESC(alA); __syncthreads();
  }
  SBAR(); qkt(pB0, pB1, (bf16*)((char*)K_lds + SHM_K), qr, r32, hi);
  finishSM(pA0, pA1, alA, l_reg, pa0, pa1, pa2, pa3); SBAR();
  pv_d0(o, vb0, pa0, pa1, pa2, pa3); partialSM(pB0, pB1, m_reg, mnB, alB);
  __syncthreads(); RESC(alB);
  finishSM(pB0, pB1, alB, l_reg, pa0, pa1, pa2, pa3); SBAR();
  pv_d0(o, vb0 + (int)SHM_V, pa0, pa1, pa2, pa3);
  if (hi == 0) li_l[r32] = l_reg; asm volatile("s_waitcnt lgkmcnt(0)" ::: "memory");
  float rli[16];
#pragma unroll
  for (int r = 0; r < 16; ++r) rli[r] = __builtin_amdgcn_rcpf(li_l[crow(r, hi)]);
  { char* stg = lds + STG_OFF + wid * STG_WAVE;
#pragma unroll
    for (int r = 0; r < 16; ++r) { const int orow = crow(r, hi);
#pragma unroll
      for (int d0 = 0; d0 < 4; ++d0) *(bf16*)(stg + orow * 272 + (d0 * 32 + r32) * 2) = __float2bfloat16(o[d0][r] * rli[r]); }
    asm volatile("s_waitcnt lgkmcnt(0)" ::: "memory");
    int lane2 = lane; asm volatile("" : "+v"(lane2), "+s"(Gb), "+s"(Ob));
#pragma unroll
    for (int i = 0; i < 8; ++i) { const int id = i * 64 + lane2, row = id >> 4, ch = id & 15;
      const u32x4 ov = *(const u32x4*)(stg + row * 272 + ch * 16);
      const u32x4 gv = *(const u32x4*)(Gb + (long)(wid * QBLK + row) * LDQ + ch * 8);
      u32x4 w;
#define SG(o_, g_) ((o_) * (g_) * __builtin_amdgcn_rcpf(1.f + __expf(-(g_))))
#define LO(x) __uint_as_float((x) << 16)
#define HI(x) __uint_as_float((x) & 0xffff0000u)
      w.x = cvtpk(SG(LO(ov.x), LO(gv.x)), SG(HI(ov.x), HI(gv.x))); w.y = cvtpk(SG(LO(ov.y), LO(gv.y)), SG(HI(ov.y), HI(gv.y)));
      w.z = cvtpk(SG(LO(ov.z), LO(gv.z)), SG(HI(ov.z), HI(gv.z))); w.w = cvtpk(SG(LO(ov.w), LO(gv.w)), SG(HI(ov.w), HI(gv.w)));
#undef SG
#undef LO
#undef HI
      *(u32x4*)(Ob + (long)(wid * QBLK + row) * LDO + ch * 8) = w; } }
  __syncthreads();
#undef SLOAD
#undef SWRITE
#undef SWAIT
#undef RESC
}
}
#undef SBAR
#undef KSWZ
#define LAS __attribute__((address_space(3)))
typedef unsigned short bf16_t;
typedef float f32x4 __attribute__((ext_vector_type(4)));
typedef unsigned u32x4 __attribute__((ext_vector_type(4)));
typedef unsigned u32x2 __attribute__((ext_vector_type(2)));
typedef short bf16x8 __attribute__((ext_vector_type(8)));

constexpr int DM = 2048, MC = 4096, ML = 8192, MT = 12288;
constexpr int INC = 5120, MGC = 6144, NCAT = INC + MGC, NCAT1 = NCAT - 2048;
constexpr int C_Q = 0, C_K = 1024, C_V = 1280, C_GA = 1536, C_U = 2560, C_VB = 3072, C_GB = 3584, C_Z = 4096, C_GC = 4608;
constexpr int KVLAT = 2304;
constexpr float EPS = 1e-6f;
constexpr size_t OFF_SK = (size_t)MT * DM, OFF_SV = OFF_SK + 16 * 2 * 256 * 256;
constexpr size_t MiB = 1u << 20;
constexpr size_t WS_ROPE = 64 * 1024, WS_MOD = 128 * 1024, WS_WPOOL = 512 * 1024;
constexpr size_t WS_WCAT = 1 * MiB, WS_WBRA = 45 * MiB, WS_WBRB = 49 * MiB, WS_WBRC = 51 * MiB, WS_WOUT = 53 * MiB;
constexpr size_t WS_MIX = 387 * MiB, WS_MERGED = 109 * MiB;
constexpr size_t WS_H = 61 * MiB, WS_PROJ = 109 * MiB, WS_GATES = 229 * MiB, WS_KB = 373 * MiB, WS_VB = 380 * MiB, WS_END = 435 * MiB;
constexpr int LDS_BYTES = 147456, LDS_CTL = 147200;
constexpr int NPH = 10;
constexpr int CW_TMO = 3500, CW_CNT = 4096;
constexpr size_t CTL_ZERO_BYTES = 65536;

__device__ __forceinline__ float bflo(unsigned u) { return __uint_as_float(u << 16); }
__device__ __forceinline__ float bfhi(unsigned u) { return __uint_as_float(u & 0xffff0000u); }
__device__ __forceinline__ unsigned f2bf(float f) { unsigned u = __float_as_uint(f); return (u + 0x7fffu + ((u >> 16) & 1u)) >> 16; }
__device__ __forceinline__ unsigned pk2(float lo, float hi) { return pg8::cvt_pk_bf16(lo, hi); }
__device__ __forceinline__ float silu_f(float g) { return g * __builtin_amdgcn_rcpf(1.f + __expf(-g)); }
__device__ __forceinline__ float wave_sum(float v) {
#pragma unroll
    for (int o = 1; o < 64; o <<= 1) v += __shfl_xor(v, o);
    return v;
}

struct Args { const float* in[24]; float* out; unsigned char* ws; int ph_lo, ph_hi; };

__host__ __device__ __forceinline__ int sig_inv(int d) { const int hi = (d >> 5) & 1, q = (d & 31) + ((d >> 6) << 5); return 8 * (q >> 2) + (q & 3) + 4 * hi; }
__device__ __forceinline__ void tr_item(const float* W, int K, int N, bf16_t* WT, int row_off, LAS float* scr, int item, int lane, int ldo = 0, int koff = 0, bool perm = false) {
    if (ldo == 0) ldo = K;
    const int nblk = N / 32, kb = item / nblk, nb = item % nblk, k0 = 64 * kb, n0 = 32 * nb;
#pragma unroll 8
    for (int i = 0; i < 32; ++i) { const int kk = 2 * i + (lane >> 5); scr[kk * 33 + (lane & 31)] = __builtin_nontemporal_load(W + (size_t)(k0 + kk) * N + n0 + (lane & 31)); }
    asm volatile("s_waitcnt lgkmcnt(0)" ::: "memory");
    const int c = lane & 7;
#pragma unroll
    for (int j = 0; j < 4; ++j) { const int n = (lane >> 3) + 8 * j; const LAS float* s = scr + (8 * c) * 33 + n;
        u32x4 o; o.x = pk2(s[0 * 33], s[1 * 33]); o.y = pk2(s[2 * 33], s[3 * 33]); o.z = pk2(s[4 * 33], s[5 * 33]); o.w = pk2(s[6 * 33], s[7 * 33]);
        int nr = row_off + n0 + n; if (perm && nr < 1280) nr = (nr & ~127) + sig_inv(nr & 127);
        *(u32x4*)(WT + (size_t)nr * ldo + koff + k0 + 8 * c) = o; }
    asm volatile("s_waitcnt lgkmcnt(0)" ::: "memory");
}
__device__ __forceinline__ void convert_weights(const Args& a, int l, LAS float* scr, int gw, int NGW, int lane, bool pool) {
    unsigned char* ws = a.ws;
    constexpr int I_IN = 32 * 160, I_MG = 32 * 192, I_A = 16 * 64, I_B = 8 * 64, I_O = 32 * 64;
    constexpr int NIT = I_IN + I_MG + I_A + 2 * I_B + I_O;
    const int nit = NIT + (pool ? 64 : 0);
    for (int it = gw; it < nit; it += NGW) {
        int r = it;
        if (r < I_IN) { tr_item(a.in[9] + (size_t)l * 2048 * 5120, 2048, 5120, (bf16_t*)(ws + WS_WCAT), 0, scr, r, lane, 0, 0, true); continue; } r -= I_IN;
        if (r < I_MG) { tr_item(a.in[20] + (size_t)l * 2048 * 6144, 2048, 6144, (bf16_t*)(ws + WS_WCAT), 5120, scr, r, lane); continue; } r -= I_MG;
        if (r < I_A) { tr_item(a.in[17] + (size_t)l * 1024 * 2048, 1024, 2048, (bf16_t*)(ws + WS_WBRA), 0, scr, r, lane, 2048, 0); continue; } r -= I_A;
        if (r < I_B) { tr_item(a.in[18] + (size_t)l * 512 * 2048, 512, 2048, (bf16_t*)(ws + WS_WBRA), 0, scr, r, lane, 2048, 1024); continue; } r -= I_B;
        if (r < I_B) { tr_item(a.in[19] + (size_t)l * 512 * 2048, 512, 2048, (bf16_t*)(ws + WS_WBRA), 0, scr, r, lane, 2048, 1536); continue; } r -= I_B;
        if (r < I_O) { tr_item(a.in[22] + (size_t)l * 2048 * 2048, 2048, 2048, (bf16_t*)(ws + WS_WOUT), 0, scr, r, lane); continue; } r -= I_O;
        { const int mat = r >> 3; tr_item(a.in[15] + (size_t)mat * 16384, 128, 128, (bf16_t*)(ws + WS_WPOOL) + (size_t)mat * 16384, 0, scr, r & 7, lane); }
    }
}

__device__ __forceinline__ void phase_prologue(const Args& a, unsigned char* lds, int tid, int lane, int wave, int bx, int G, int gw, int NGW) {
    float* mod = (float*)(a.ws + WS_MOD);
    for (int u = bx; u < 192; u += G) {
        const int l = u / 96, cb = u % 96;
        LAS float* sv = (LAS float*)lds; LAS float* red = sv + 5 * 2048;
        for (int i = tid; i < 5 * 2048; i += 512) { const int j = i >> 11, k = i & 2047; const float c = (j == 0) ? a.in[5][k] : a.in[4][(j - 1) * 2048 + k]; sv[i] = c / (1.f + __expf(-c)); }
        __syncthreads();
        const float* W = a.in[7] + (size_t)l * 2048 * 6144 + cb * 64 + lane;
        float a0 = 0.f, a1 = 0.f, a2 = 0.f, a3 = 0.f, a4 = 0.f;
        const int k0 = wave * 256;
#pragma unroll 32
        for (int k = k0; k < k0 + 256; ++k) { const float w = __builtin_nontemporal_load(W + (size_t)k * 6144); a0 += sv[k] * w; a1 += sv[2048 + k] * w; a2 += sv[4096 + k] * w; a3 += sv[6144 + k] * w; a4 += sv[8192 + k] * w; }
        red[(wave * 5 + 0) * 64 + lane] = a0; red[(wave * 5 + 1) * 64 + lane] = a1; red[(wave * 5 + 2) * 64 + lane] = a2; red[(wave * 5 + 3) * 64 + lane] = a3; red[(wave * 5 + 4) * 64 + lane] = a4;
        __syncthreads();
        if (tid < 320) { const int j = tid >> 6; float s = 0.f;
#pragma unroll
            for (int w = 0; w < 8; ++w) s += red[(w * 5 + j) * 64 + lane];
            const int col = cb * 64 + lane; mod[(size_t)(l * 5 + j) * 6144 + col] = s + a.in[8][l * 6144 + col]; }
        __syncthreads();
    }
    if (bx == G - 1 && wave == 7 && lane < 32) {
        double inv = 1.0; for (int i = 0; i < lane; ++i) inv *= 0.7498942093324559;
        const double x2 = inv * inv; double c = 1.0, s = inv, tc = 1.0, ts = inv;
        for (int n = 1; n <= 12; ++n) { tc *= -x2 / (double)((2 * n - 1) * (2 * n)); ts *= -x2 / (double)((2 * n) * (2 * n + 1)); c += tc; s += ts; }
        float* tab = (float*)(a.ws + WS_ROPE); double cr = 1.0, sr = 0.0;
        for (int p = 0; p < 64; ++p) { tab[(p * 32 + lane) * 2] = (float)cr; tab[(p * 32 + lane) * 2 + 1] = (float)sr; const double ncr = cr * c - sr * s; sr = sr * c + cr * s; cr = ncr; }
    }
    convert_weights(a, 0, (LAS float*)((LAS unsigned char*)lds + wave * 16384), gw, NGW, lane, true);
}

__device__ __forceinline__ void phase_norm(const Args& a, int l, int gw, int NGW, int lane) {
    const float* xc = l == 0 ? a.in[0] : a.out; const float* xl = l == 0 ? a.in[1] : a.out + (size_t)MC * DM;
    const float* nw = a.in[6] + l * DM; const float* mod = (const float*)(a.ws + WS_MOD) + (size_t)l * 5 * 6144;
    bf16_t* H = (bf16_t*)(a.ws + WS_H);
    for (int m = gw; m < MT; m += NGW) {
        const float* xr = (m < MC) ? xc + (size_t)m * DM : xl + (size_t)(m - MC) * DM;
        const float* md = mod + ((m < MC) ? 0 : 1 + ((m - MC) >> 11)) * 6144;
        f32x4 v[8]; float s = 0.f;
#pragma unroll
        for (int j = 0; j < 8; ++j) { v[j] = ((const f32x4*)xr)[lane + 64 * j]; s += (v[j].x * v[j].x + v[j].y * v[j].y) + (v[j].z * v[j].z + v[j].w * v[j].w); }
        const float rstd = 1.f / sqrtf(wave_sum(s) * (1.f / DM) + EPS);
#pragma unroll
        for (int j = 0; j < 8; ++j) { const int col = 4 * (lane + 64 * j);
            const f32x4 w = *(const f32x4*)(nw + col), sh = *(const f32x4*)(md + col), sc = *(const f32x4*)(md + 2048 + col);
            const f32x4 y = v[j] * rstd * w * (sc + 1.f) + sh; u32x2 o; o.x = pk2(y.x, y.y); o.y = pk2(y.z, y.w);
            *(u32x2*)(H + (size_t)m * DM + col) = o; }
    }
}
__device__ __forceinline__ void cache_rows(const Args& a, int l, int gw, int NGW, int lane) {
    bf16_t* KB = (bf16_t*)(a.ws + WS_KB); bf16_t* VB = (bf16_t*)(a.ws + WS_VB);
    for (int i = gw; i < 1024; i += NGW) { const int b = i >> 8, jj = i & 255; const size_t src = ((size_t)(b * 2 + l) * 256 + jj) * 256, dst = ((size_t)MC + (size_t)b * KVLAT + 2048 + jj) * 256 + 4 * lane;
        const int p4 = (4 * lane) & 127, kh = (4 * lane) >> 7, q = 4 * (p4 >> 3) + 0, bs = (q < 32 ? q : q + 32) + ((p4 & 4) ? 32 : 0);
        const f32x4 k = *(const f32x4*)(a.in[2] + src + kh * 128 + bs), v = *(const f32x4*)(a.in[3] + src + 4 * lane);
        u32x2 ko, vo; ko.x = pk2(k.x, k.y); ko.y = pk2(k.z, k.w); vo.x = pk2(v.x, v.y); vo.y = pk2(v.z, v.w);
        *(u32x2*)(KB + dst) = ko; *(u32x2*)(VB + dst) = vo; }
}
__device__ __forceinline__ void phase_final(const Args& a, int gw, int NGW, int lane) {
    const float* nw = a.in[23];
    for (int m = gw; m < MT; m += NGW) {
        float* xr = a.out + (size_t)m * DM; f32x4 v[8]; float s = 0.f;
#pragma unroll
        for (int j = 0; j < 8; ++j) { v[j] = ((const f32x4*)xr)[lane + 64 * j]; s += (v[j].x * v[j].x + v[j].y * v[j].y) + (v[j].z * v[j].z + v[j].w * v[j].w); }
        const float rstd = 1.f / sqrtf(wave_sum(s) * (1.f / DM) + EPS);
#pragma unroll
        for (int j = 0; j < 8; ++j) { const int col = 4 * (lane + 64 * j); __builtin_nontemporal_store(v[j] * rstd * *(const f32x4*)(nw + col), (f32x4*)xr + lane + 64 * j); }
    }
}

__device__ __forceinline__ void unpack8(const u32x4 v, float* x) { x[0] = bflo(v.x); x[1] = bfhi(v.x); x[2] = bflo(v.y); x[3] = bfhi(v.y); x[4] = bflo(v.z); x[5] = bfhi(v.z); x[6] = bflo(v.w); x[7] = bfhi(v.w); }
__device__ __forceinline__ u32x4 pack8(const float* x) { u32x4 o; o.x = pk2(x[0], x[1]); o.y = pk2(x[2], x[3]); o.z = pk2(x[4], x[5]); o.w = pk2(x[6], x[7]); return o; }
__device__ __forceinline__ void mm128(const LAS unsigned char* X, const LAS unsigned char* Y, int wave, int fr, int fq, f32x4 (&acc)[8]) {
    bf16x8 yb[4];
#pragma unroll
    for (int k = 0; k < 4; ++k) yb[k] = *(const LAS bf16x8*)(Y + (16 * wave + fr) * 272 + (k * 32 + fq * 8) * 2);
#pragma unroll
    for (int cb = 0; cb < 8; ++cb) { acc[cb] = (f32x4){0.f, 0.f, 0.f, 0.f};
#pragma unroll
        for (int k = 0; k < 4; ++k) { const bf16x8 xa = *(const LAS bf16x8*)(X + (16 * cb + fr) * 272 + (k * 32 + fq * 8) * 2);
            acc[cb] = __builtin_amdgcn_mfma_f32_16x16x32_bf16(xa, yb[k], acc[cb], 0, 0, 0); } }
}
constexpr int P3_X = 0, P3_Y = 34816, P3_Z = 69632;
__device__ __forceinline__ void sgu_unit(const Args& a, int l, int n, int g0, int g1, LAS unsigned char* lds, int tid, int lane, int wave) {
    bf16_t* PROJ = (bf16_t*)(a.ws + WS_PROJ); bf16_t* MIX = (bf16_t*)(a.ws + WS_MIX);
    asm volatile("" : "+v"(tid), "+v"(lane));
    const int q = tid >> 2, part = tid & 3, fr = lane & 15, fq = lane >> 4;
    const size_t rowoff = (size_t)(128 * n + q) * INC;
    u32x4 rv[16], xr[2][4]; f32x4 yr[2][8];
    { const bf16_t* p = PROJ + rowoff + C_VB + part * 128;
#pragma unroll
      for (int i = 0; i < 16; ++i) rv[i] = *(const u32x4*)(p + 8 * i); }
#pragma unroll
    for (int gi = 0; gi < 2; ++gi) { const int g = g0 + gi; const bf16_t* p = PROJ + rowoff + C_VB + g * 128 + part * 32; const float* W = a.in[13] + ((size_t)(l * 4 + g) * 128 + q) * 128 + part * 32;
#pragma unroll
        for (int i = 0; i < 4; ++i) xr[gi][i] = *(const u32x4*)(p + 8 * i);
#pragma unroll
        for (int i = 0; i < 8; ++i) yr[gi][i] = *(const f32x4*)(W + 4 * i); }
    float ss = 0.f;
#pragma unroll
    for (int i = 0; i < 16; ++i) { float f[8]; unpack8(rv[i], f);
#pragma unroll
        for (int e = 0; e < 8; ++e) ss += f[e] * f[e]; }
    ss += __shfl_xor(ss, 1); ss += __shfl_xor(ss, 2);
    const float rs = 1.f / sqrtf(ss * (1.f / 512.f) + EPS);
#pragma unroll
    for (int gi = 0; gi < 2; ++gi) { const int g = g0 + gi; LAS unsigned char* X = lds + gi * 69632 + P3_X; LAS unsigned char* Y = lds + gi * 69632 + P3_Y;
        const float* nw = a.in[12] + l * 512 + g * 128 + part * 32;
#pragma unroll
        for (int i = 0; i < 4; ++i) { float f[8]; unpack8(xr[gi][i], f); const f32x4 n0 = *(const f32x4*)(nw + 8 * i), n1 = *(const f32x4*)(nw + 8 * i + 4);
#pragma unroll
            for (int e = 0; e < 8; ++e) *(LAS bf16_t*)(X + (part * 32 + 8 * i + e) * 272 + q * 2) = (bf16_t)f2bf(f[e] * rs * (e < 4 ? n0[e] : n1[e - 4])); }
#pragma unroll
        for (int i = 0; i < 4; ++i) { const f32x4 w0 = yr[gi][2 * i], w1 = yr[gi][2 * i + 1];
            u32x4 o; o.x = pk2(w0.x, w0.y); o.y = pk2(w0.z, w0.w); o.z = pk2(w1.x, w1.y); o.w = pk2(w1.z, w1.w);
            *(LAS u32x4*)(Y + q * 272 + (part * 32 + 8 * i) * 2) = o; } }
    __syncthreads();
    const int p = 16 * wave + fr; const size_t ro = (size_t)(128 * n + p) * INC;
#pragma unroll
    for (int gi = 0; gi < 2; ++gi) { const int g = g0 + gi;
        u32x2 uu[8], gg[8];
#pragma unroll
        for (int cb = 0; cb < 8; ++cb) { const int c = g * 128 + 16 * cb + 4 * fq; uu[cb] = *(const u32x2*)(PROJ + ro + C_U + c); gg[cb] = *(const u32x2*)(PROJ + ro + C_GB + c); }
        const float bs = a.in[14][(l * 4 + g) * 128 + p];
        f32x4 acc[8]; mm128(lds + gi * 69632 + P3_X, lds + gi * 69632 + P3_Y, wave, fr, fq, acc);
#pragma unroll
        for (int cb = 0; cb < 8; ++cb) { const int c = g * 128 + 16 * cb + 4 * fq;
            const float v0 = bflo(uu[cb].x) * (acc[cb].x + bs) * silu_f(bflo(gg[cb].x)), v1 = bfhi(uu[cb].x) * (acc[cb].y + bs) * silu_f(bfhi(gg[cb].x));
            const float v2 = bflo(uu[cb].y) * (acc[cb].z + bs) * silu_f(bflo(gg[cb].y)), v3 = bfhi(uu[cb].y) * (acc[cb].w + bs) * silu_f(bfhi(gg[cb].y));
            u32x2 o; o.x = pk2(v0, v1); o.y = pk2(v2, v3); *(u32x2*)(MIX + (size_t)(128 * n + p) * DM + 1024 + c) = o; } }
    __syncthreads();
}
__device__ __forceinline__ void pool_unit(const Args& a, int l, int n, int g0, int g1, LAS unsigned char* lds, int tid, int lane, int wave) {
    bf16_t* PROJ = (bf16_t*)(a.ws + WS_PROJ); bf16_t* MIX = (bf16_t*)(a.ws + WS_MIX);
    LAS unsigned char* X = lds + P3_X; LAS unsigned char* Y = lds + P3_Y; LAS float* Z = (LAS float*)(lds + P3_Z);
    const int row0 = 128 * n; const bool lat = row0 >= MC; const int seqlen = lat ? 2048 : 256; const int t0 = lat ? ((row0 - MC) & 2047) : (row0 & 255);
    asm volatile("" : "+v"(tid), "+v"(lane));
    const int fr = lane & 15, fq = lane >> 4;
    u32x4 zr[5], xw[4];
#define POOL_PREFETCH(gi_) do { _Pragma("unroll") for (int i = 0; i < 5; ++i) { const int ch = tid + 512 * i; const int r = ch >> 4, c8 = (ch & 15) * 8, pos = t0 - 8 + r; \
            zr[i] = (u32x4){0u, 0u, 0u, 0u}; if (ch < 144 * 16 && pos >= 0 && pos < seqlen) zr[i] = *(const u32x4*)(PROJ + (size_t)(row0 - 8 + r) * INC + C_Z + (gi_) * 128 + c8); } \
        { const bf16_t* WP = (const bf16_t*)(a.ws + WS_WPOOL) + (size_t)(l * 4 + (gi_)) * 16384 + (tid >> 2) * 128 + (tid & 3) * 32; \
          _Pragma("unroll") for (int i = 0; i < 4; ++i) xw[i] = *(const u32x4*)(WP + 8 * i); } } while (0)
    POOL_PREFETCH(g0);
    for (int gi = g0; gi < g1; ++gi) {
        const int w = 2 << gi, hw = w >> 1;
#pragma unroll
        for (int i = 0; i < 5; ++i) { const int ch = tid + 512 * i; if (ch < 144 * 16) { const int r = ch >> 4, c8 = (ch & 15) * 8; float f[8]; unpack8(zr[i], f);
            *(LAS f32x4*)(Z + r * 128 + c8) = (f32x4){f[0], f[1], f[2], f[3]}; *(LAS f32x4*)(Z + r * 128 + c8 + 4) = (f32x4){f[4], f[5], f[6], f[7]}; } }
#pragma unroll
        for (int i = 0; i < 4; ++i) *(LAS u32x4*)(X + (tid >> 2) * 272 + ((tid & 3) * 32 + 8 * i) * 2) = xw[i];
        if (gi + 1 < g1) POOL_PREFETCH(gi + 1);
        const int tl = 16 * wave + fr; const size_t ro = (size_t)(row0 + tl) * INC;
        u32x2 gg[8]; f32x4 ps[8];
#pragma unroll
        for (int cb = 0; cb < 8; ++cb) { const int dch = gi * 128 + 16 * cb + 4 * fq; ps[cb] = *(const f32x4*)(a.in[16] + l * 512 + dch); gg[cb] = *(const u32x2*)(PROJ + ro + C_GC + dch); }
        __syncthreads();
        { const int c = tid & 127, t = 32 * (tid >> 7); float s = 0.f;
          for (int k = 0; k < w; ++k) s += Z[(t + 8 - hw + k) * 128 + c];
          for (int tt = 0; tt < 32; ++tt) { const int tl2 = t + tt, pos = t0 + tl2; const int lo = max(pos - hw, 0), hi = min(pos + w - hw, seqlen);
              const float dv = s / (float)(hi - lo) - Z[(tl2 + 8) * 128 + c];
              *(LAS bf16_t*)(Y + tl2 * 272 + c * 2) = (bf16_t)f2bf(dv);
              s += Z[(tl2 + 8 - hw + w) * 128 + c] - Z[(tl2 + 8 - hw) * 128 + c]; } }
        __syncthreads();
        f32x4 acc[8]; mm128(X, Y, wave, fr, fq, acc);
#pragma unroll
        for (int cb = 0; cb < 8; ++cb) { const int dch = gi * 128 + 16 * cb + 4 * fq;
            u32x2 o; o.x = pk2(acc[cb].x * ps[cb].x * silu_f(bflo(gg[cb].x)), acc[cb].y * ps[cb].y * silu_f(bfhi(gg[cb].x))); o.y = pk2(acc[cb].z * ps[cb].z * silu_f(bflo(gg[cb].y)), acc[cb].w * ps[cb].w * silu_f(bfhi(gg[cb].y)));
            *(u32x2*)(MIX + (size_t)(row0 + tl) * DM + 1536 + dch) = o; }
        __syncthreads();
    }
#undef POOL_PREFETCH
}
#define RLX_AGENT __ATOMIC_RELAXED, __HIP_MEMORY_SCOPE_AGENT
#define XB_TMO      128
#define XB_XCNT(j)  (256  + 64 * (j))
#define XB_XSUB(j)  (1280 + 64 * (j))
#define XB_XGEN(j)  (2304 + 64 * (j))
#define XB_TOP      3328
#define XB_TOPGEN   3392
#define XCD_BAR_WORDS 3456
#define XB_SPIN_CAP (1u << 18)

__device__ __forceinline__ unsigned xb_ld(unsigned* p)              { return __hip_atomic_load(p, __ATOMIC_RELAXED, __HIP_MEMORY_SCOPE_AGENT); }
__device__ __forceinline__ unsigned xb_add(unsigned* p, unsigned v) { return __hip_atomic_fetch_add(p, v, __ATOMIC_RELAXED, __HIP_MEMORY_SCOPE_AGENT); }
__device__ __forceinline__ unsigned xb_xcc_id() { return (unsigned)__builtin_amdgcn_s_getreg((3 << 11) | 20) & 0xFu; }
#define XB_SPIN(cond, bar) do { unsigned _sp = 0; while (cond) { __builtin_amdgcn_s_sleep(1); \
    if ((++_sp & 255u) == 0u) { if (xb_ld(&(bar)[XB_TMO])) break; if (_sp > XB_SPIN_CAP) { atomicAdd(&(bar)[XB_TMO], 1u); break; } } } } while (0)

struct XcdBarrier {
    unsigned* bar; unsigned x;
    volatile LAS unsigned* st;
};

__device__ __forceinline__ XcdBarrier xcd_barrier_post(unsigned* bar, volatile LAS unsigned* st) {
    XcdBarrier b; b.bar = bar; b.x = xb_xcc_id(); b.st = st;
    if (threadIdx.x == 0) (void)xb_add(&bar[XB_XCNT(b.x)], 1u);
    return b;
}
__device__ __forceinline__ void xcd_barrier_complete(unsigned* bar, unsigned x, unsigned& nloc, unsigned& nx) {
    const unsigned G = gridDim.x * gridDim.y * gridDim.z;
    unsigned sum, cnt, mine, sp = 0u;
    for (;;) {
        sum = 0u; cnt = 0u; mine = 0u;
#pragma unroll
        for (unsigned j = 0; j < 16; ++j) { const unsigned c = xb_ld(&bar[XB_XCNT(j)]); sum += c; cnt += (c > 0u) ? 1u : 0u; mine = (j == x) ? c : mine; }
        if (sum == G) break;
        __builtin_amdgcn_s_sleep(1);
        if ((++sp & 255u) == 0u) { if (xb_ld(&bar[XB_TMO])) break; if (sp > XB_SPIN_CAP) { atomicAdd(&bar[XB_TMO], 1u); break; } }
    }
    nloc = mine > 0u ? mine : 1u; nx = cnt > 0u ? cnt : 1u;
}

__device__ __forceinline__ void xcd_barrier(const XcdBarrier& b) {
    asm volatile("s_waitcnt vmcnt(0)" ::: "memory");
    __syncthreads();
    if (threadIdx.x == 0) {
        unsigned* bar = b.bar;
        __builtin_amdgcn_s_waitcnt(0);
        unsigned nloc = b.st[0], nx = b.st[1];
        if (nloc == 0u) { xcd_barrier_complete(bar, b.x, nloc, nx); b.st[0] = nloc; b.st[1] = nx; }
        const unsigned old = xb_add(&bar[XB_XSUB(b.x)], 1u);
        const unsigned gen = old / nloc;
        if (old + 1u == (gen + 1u) * nloc) {
            __builtin_amdgcn_fence(__ATOMIC_RELEASE, "agent");
            asm volatile("s_waitcnt vmcnt(0)" ::: "memory");
            const unsigned og = xb_add(&bar[XB_TOP], 1u);
            const unsigned tg = og / nx;
            if (og + 1u == (tg + 1u) * nx) xb_add(&bar[XB_TOPGEN], 1u);
            else XB_SPIN(xb_ld(&bar[XB_TOPGEN]) == tg, bar);
            __builtin_amdgcn_fence(__ATOMIC_ACQUIRE, "agent");
            xb_add(&bar[XB_XGEN(b.x)], 1u);
            asm volatile("s_waitcnt vmcnt(0)" ::: "memory");
        } else {
            XB_SPIN(xb_ld(&bar[XB_XGEN(b.x)]) == gen, bar);
            __builtin_amdgcn_fence(__ATOMIC_ACQUIRE, "agent");
            asm volatile("s_waitcnt vmcnt(0)" ::: "memory");
        }
    }
    __syncthreads();
}
#if defined(__HIP_DEVICE_COMPILE__)
#define LOAD_ARGS asm volatile("" : "+s"(ap)); const Args a = *ap; unsigned char* ws = a.ws; (void)ws
#else
#define LOAD_ARGS const Args a = a_unused; unsigned char* ws = a.ws; (void)ws
#endif
#ifndef PH_EN
#define PH_EN 0xff
#endif
#ifndef PROBE_PH
#define PROBE_PH 0
#endif
#ifndef PROBE_N
#define PROBE_N 0
#endif
#ifndef PROBE_MASK
#define PROBE_MASK 15
#endif
__global__ void __launch_bounds__(512, 2) mk_fwd(Args a_unused) {
    extern __shared__ __attribute__((aligned(16))) unsigned char lds[];
    if (threadIdx.x < 16) ((LAS unsigned*)((LAS unsigned char*)lds + LDS_CTL))[threadIdx.x] = 0u;
    __syncthreads();
    XcdBarrier bar = xcd_barrier_post((unsigned*)a_unused.ws + 0, (volatile LAS unsigned*)((LAS unsigned char*)lds + LDS_CTL));
    LAS unsigned char* L = (LAS unsigned char*)lds;
    typedef const __attribute__((address_space(4))) Args CArgs;
    CArgs* ap = (CArgs*)__builtin_amdgcn_kernarg_segment_ptr();
    (void)bar;
    for (int ph = 0; ; ++ph) {
        asm volatile("" : "+s"(ap));
        if (ph >= ap->ph_hi) break;
        if (ph > 0) { XcdBarrier b2; b2.bar = (unsigned*)ap->ws; b2.x = xb_xcc_id(); b2.st = (volatile LAS unsigned*)((LAS unsigned char*)lds + LDS_CTL); xcd_barrier(b2); }
        asm volatile("" : "+s"(ap));
        int tid = threadIdx.x, G = gridDim.x, bx = blockIdx.x;
        asm volatile("" : "+v"(tid), "+s"(G), "+s"(bx));
        const int lane = tid & 63, wave = __builtin_amdgcn_readfirstlane(tid >> 6);
        const int vcu = (G % 8 == 0) ? (bx % 8) * (G / 8) + bx / 8 : bx;
        const int gw = vcu * 8 + wave, NGW = G * 8;
        const bool probe = (PROBE_N > 0) && ph >= NPH; const int eph = probe ? PROBE_PH : ph;
        if (eph == 0) { LOAD_ARGS; if (PH_EN & 1) phase_prologue(a, lds, tid, lane, wave, bx, G, gw, NGW); continue; }
        if (eph == NPH - 1) { LOAD_ARGS; if (PH_EN & 128) phase_final(a, gw, NGW, lane); continue; }
        const int l = (eph - 1) / 4, s = (eph - 1) % 4;
        if (s == 0 && (PH_EN & 2)) { LOAD_ARGS;
            phase_norm(a, l, gw, NGW, lane);
            cache_rows(a, l, gw, NGW, lane);
            if (l == 1) convert_weights(a, 1, (LAS float*)(L + wave * 16384), gw, NGW, lane, false);
        } else if (s == 1 && (PH_EN & 4)) { LOAD_ARGS;
            pg8::Gemm g{(const bf16_t*)(ws + WS_H), (const bf16_t*)(ws + WS_WCAT), MT, NCAT1, DM, DM}; pg8::Gemm1Order S; S.init(MT, NCAT1, G, bx);
            pg8::EpiProj E{(bf16_t*)(ws + WS_PROJ), (bf16_t*)(ws + WS_GATES), a.in[21] + l * MGC, (probe && (PROBE_MASK & 16)) ? 1 : 0, 0, ws, a.out, a.in[10] + l * 128, a.in[11] + l * 128, l, (PG8_LAS float*)(L + 131072)};
            pg8::gemm_phase<pg8::EpiProj, pg8::Gemm1Order, true, true>(L, g, S, E);
        } else if (s == 2 && (PH_EN & 16)) { LOAD_ARGS;
            const att::bf16* PROJ = (const att::bf16*)(ws + WS_PROJ); const att::bf16* KB = (const att::bf16*)(ws + WS_KB); const att::bf16* VB = (const att::bf16*)(ws + WS_VB);
            att::bf16* MIX = (att::bf16*)(ws + WS_MIX);
            if (!probe || (PROBE_MASK & 32)) {
                pg8::Gemm g{(const bf16_t*)(ws + WS_H), (const bf16_t*)(ws + WS_WCAT) + (size_t)NCAT1 * DM, MT, 2048, DM, DM}; pg8::DeferOrder S{G, bx};
                pg8::EpiProj E{(bf16_t*)(ws + WS_PROJ), (bf16_t*)(ws + WS_GATES), a.in[21] + l * MGC, 0, 36, ws, a.out, a.in[10] + l * 128, a.in[11] + l * 128, l, (PG8_LAS float*)(L + 131072)};
                pg8::gemm_phase<pg8::EpiProj, pg8::DeferOrder, true, true>(L, g, S, E);
            }
            for (int k = 0; ; ++k) {
                int u;
                if (G == 256) { const int cc = bx - 64; if (k > (bx < 64 ? 0 : (cc < 128 ? 3 : 2))) break; u = (k == 0) ? vcu : 256 + (k - 1) * 192 + cc; }
                else { u = vcu + k * G; if (u >= 768) break; }
                const int sm = u - 256;
                if (probe) { const int kind = u < 256 ? 1 : (sm < 192 ? 2 : (sm < 384 ? 4 : 8)); if (!(PROBE_MASK & kind)) continue; }
                if (u >= 256 && sm < 384) {
#if defined(__HIP_DEVICE_COMPILE__)
                    asm volatile("" : "+s"(ap)); const Args a2 = *ap;
#else
                    const Args a2 = a_unused;
#endif
                    if (sm < 192) sgu_unit(a2, l, sm >> 1, (sm & 1) * 2, (sm & 1) * 2 + 2, L, tid, lane, wave);
                    else { const int pu = sm - 192; pool_unit(a2, l, pu >> 1, (pu & 1) * 2, (pu & 1) * 2 + 2, L, tid, lane, wave); }
                    continue; }
                int qrow0, kvrow0, h, seq;
                if (u < 256) { const int b = u >> 6, qb = u & 7; h = (u >> 3) & 7; qrow0 = MC + b * 2048 + qb * 256; kvrow0 = MC + b * KVLAT; seq = KVLAT; }
                else { const int uu = sm - 384, b = uu >> 3; h = uu & 7; qrow0 = b * 256; kvrow0 = b * 256; seq = 256; }
                const att::bf16* Q = PROJ + (size_t)qrow0 * INC + h * 128; const size_t ko = (size_t)kvrow0 * 256 + (h >> 2) * 128;
                att::attn_dense_body<att::bf16>(Q, KB + ko, VB + ko, Q + C_GA, MIX + (size_t)qrow0 * DM + h * 128, seq, (char*)lds);
            }
        } else if (s == 3 && (PH_EN & 32)) { LOAD_ARGS;
            pg8::Gemm2 g{(const bf16_t*)(ws + WS_MIX), (const bf16_t*)(ws + WS_WBRA), (const bf16_t*)(ws + WS_MERGED), (const bf16_t*)(ws + WS_WOUT), MT, DM, DM, DM};
            pg8::FusedOrder S{G, bx, (unsigned*)ws + CW_CNT + l * 4096};
            pg8::EpiFused E{ws, l == 0 ? a.in[0] : a.out, l == 0 ? a.in[1] : a.out + (size_t)MC * DM, a.out, l, WS_MERGED, WS_GATES, WS_MOD, probe ? 1 : 0};
            pg8::gemm_fused<pg8::EpiFused, pg8::FusedOrder, true, true>(L, g, S, E);
        }
    }
}

extern "C" void kernel_launch(void* const* d_in, const int* in_sizes, int n_in, void* d_out, int out_size, void* d_ws, size_t ws_size, hipStream_t stream) {
    static int grid = 0;
    if (grid == 0) {
        if (n_in != 24 || ws_size < WS_END) { fprintf(stderr, "kernel_launch: expected 24 inputs and >= %zu bytes of workspace; got %d, %zu\n", (size_t)WS_END, n_in, ws_size); grid = -1; return; }
        int dev = 0, cus = 0, per_cu = 0;
        if (hipGetDevice(&dev) != hipSuccess || hipDeviceGetAttribute(&cus, hipDeviceAttributeMultiprocessorCount, dev) != hipSuccess) { grid = -1; return; }
        if (hipFuncSetAttribute((const void*)mk_fwd, hipFuncAttributeMaxDynamicSharedMemorySize, LDS_BYTES) != hipSuccess) { fprintf(stderr, "kernel_launch: hipFuncSetAttribute failed\n"); grid = -1; return; }
        if (hipOccupancyMaxActiveBlocksPerMultiprocessor(&per_cu, (const void*)mk_fwd, 512, LDS_BYTES) != hipSuccess || per_cu < 1) { fprintf(stderr, "kernel_launch: occupancy query says %d\n", per_cu); per_cu = 1; }
        (void)hipGetLastError();
        grid = cus;
        fprintf(stderr, "kernel_launch: cus %d per_cu %d grid %d ws %zu\n", cus, per_cu, grid, ws_size);
    }
    if (grid < 0) return;
    Args a{};
    for (int i = 0; i < 24; ++i) a.in[i] = (const float*)d_in[i];
    a.out = (float*)d_out; a.ws = (unsigned char*)d_ws;
    a.ph_lo = 0; a.ph_hi = NPH + PROBE_N;
    if (hipMemsetAsync(d_ws, 0, CTL_ZERO_BYTES, stream) != hipSuccess) { fprintf(stderr, "kernel_launch: memset failed\n"); return; }
    hipLaunchKernelGGL(mk_fwd, dim3(grid), dim3(512), LDS_BYTES, stream, a);
}
```
